# Optimizing an MI355X kernel written in HIP

```python
import math
import jax, jax.numpy as jnp
from jax import lax
import numpy as np

D_MODEL = 1024
BATCH = 8
SEQ = 4096
DEPTH = 1

GRID_W = 64
CTX_LEN = 256
N_MOD = 9
FFN_DIM = 2816
RMS_EPS = 1e-6
S5_WIDTH = 512
S5_GROUP = 16
S5_GROUPS = S5_WIDTH // S5_GROUP
S5_STATE = 64
RWKV_WIDTH = 512
RWKV_HEAD = 64
RWKV_HEADS = RWKV_WIDTH // RWKV_HEAD
DECAY_LORA = 64
AAA_LORA = 64
GATE_LORA = 128
LN_X_EPS = 64e-5
CONV_K = 3
IN_COLS = S5_WIDTH + 3 * RWKV_WIDTH + 2 * DECAY_LORA + 2 * AAA_LORA + GATE_LORA + 2 * D_MODEL

kernel_name = 'hybrid_s5_rwkv7_macaron_prefix_dit'


def rmsnorm(x, g):
    xf = x.astype(jnp.float32)
    y = xf * lax.rsqrt(jnp.mean(xf * xf, axis=-1, keepdims=True) + RMS_EPS)
    return (y * g.astype(jnp.float32)).astype(x.dtype)


def modulate(x, g, shift, scale):
    return rmsnorm(x, g) * (1.0 + scale) + shift


def half_ffn(x, mod, j, g, w_gate, w_up, w_down):
    h = modulate(x, g, mod[3 * j], mod[3 * j + 1])
    y = (jax.nn.silu(h @ w_gate) * (h @ w_up)) @ w_down
    return x + 0.5 * mod[3 * j + 2] * y


def centred_conv(x, w, rows):
    b, n, ch = x.shape
    img = x.reshape(b, rows, n // rows, ch)
    out = lax.conv_general_dilated(img, w[:, :, None, :].astype(x.dtype), window_strides=(1, 1), padding='SAME',
                                   dimension_numbers=('NHWC', 'HWIO', 'NHWC'), feature_group_count=ch)
    return out.reshape(b, n, ch)


def _cmul(ar, ai, br, bi):
    return ar * br - ai * bi, ar * bi + ai * br


def _s5_combine(e1, e2):
    a1r, a1i, b1r, b1i = e1
    a2r, a2i, b2r, b2i = e2
    ar, ai = _cmul(a2r, a2i, a1r, a1i)
    br, bi = _cmul(a2r, a2i, b1r, b1i)
    return ar, ai, br + b2r, bi + b2i


def s5_scan(u, lam_re, lam_im, log_dt, b_re, b_im, c_re, c_im, h0_re, h0_im, reverse):
    f32 = jnp.float32
    lam_re = lam_re.astype(f32)
    lam_im = lam_im.astype(f32)
    dt = jnp.exp(log_dt.astype(f32))[:, None]
    mag = jnp.exp(dt * lam_re)
    ab_re = mag * jnp.cos(dt * lam_im)
    ab_im = mag * jnp.sin(dt * lam_im)
    den = lam_re * lam_re + lam_im * lam_im
    z_re = ((ab_re - 1.0) * lam_re + ab_im * lam_im) / den
    z_im = (ab_im * lam_re - (ab_re - 1.0) * lam_im) / den
    bb_re, bb_im = _cmul(z_re[..., None], z_im[..., None], b_re.astype(f32), b_im.astype(f32))
    if reverse:
        u = u[:, ::-1]
    xr = jnp.einsum('blgi,gpi->lbgp', u, bb_re)
    xi = jnp.einsum('blgi,gpi->lbgp', u, bb_im)
    hr, hi = _cmul(ab_re, ab_im, h0_re, h0_im)
    xr = xr.at[0].add(hr)
    xi = xi.at[0].add(hi)
    n = u.shape[1]
    a_re = jnp.broadcast_to(ab_re, (n, 1) + ab_re.shape)
    a_im = jnp.broadcast_to(ab_im, (n, 1) + ab_im.shape)
    _, _, s_re, s_im = lax.associative_scan(_s5_combine, (a_re, a_im, xr, xi), axis=0)
    y = jnp.einsum('lbgp,gip->blgi', s_re, c_re.astype(f32)) - jnp.einsum('lbgp,gip->blgi', s_im, c_im.astype(f32))
    if reverse:
        y = y[:, ::-1]
    return y, s_re[-1], s_im[-1]


def rwkv_step(S, inp):
    r, w, k, v, aa, bb = inp
    sa = jnp.einsum('bhij,bhj->bhi', S, aa)
    S = S * w[:, :, None, :] + sa[..., None] * bb[:, :, None, :] + v[..., None] * k[:, :, None, :]
    return S, jnp.einsum('bhij,bhj->bhi', S, r)


def rwkv_scan(r, w, k, v, aa, bb, S0, reverse):
    xs = (r.transpose(1, 0, 2, 3), w.transpose(1, 0, 2, 3), k.transpose(1, 0, 2, 3),
          v.transpose(1, 0, 2, 3), aa.transpose(1, 0, 2, 3), bb.transpose(1, 0, 2, 3))
    S, ys = lax.scan(rwkv_step, S0, xs, reverse=reverse)
    return ys.transpose(1, 0, 2, 3), S


def zero_states(b):
    zs = jnp.zeros((b, S5_GROUPS, S5_STATE), jnp.float32)
    zr = jnp.zeros((b, RWKV_HEADS, RWKV_HEAD, RWKV_HEAD), jnp.float32)
    return (zs, zs, zs, zs, zr, zr)


def token_mixers(h, rows, init, p, need_out):
    b, n, _ = h.shape
    f32 = jnp.float32
    proj = h @ p['w_in']
    o1 = S5_WIDTH
    o2 = o1 + 3 * RWKV_WIDTH
    o3 = o2 + 2 * DECAY_LORA
    o4 = o3 + 2 * AAA_LORA
    o5 = o4 + GATE_LORA
    o6 = o5 + D_MODEL
    u = proj[..., :o1].astype(f32)
    rkv = proj[..., o1:o2]
    wd = proj[..., o2:o3].astype(f32).reshape(b, n, 2, DECAY_LORA)
    ad = proj[..., o3:o4].astype(f32).reshape(b, n, 2, AAA_LORA)
    gd = proj[..., o4:o5].astype(f32)
    gate_a = proj[..., o5:o6]
    gate_b = proj[..., o6:]

    ug = u.reshape(b, n, S5_GROUPS, S5_GROUP)
    ya_f, sf_re, sf_im = s5_scan(ug, p['s5_A_re'][0], p['s5_A_im'][0], p['s5_log_dt'][0], p['s5_B_re'][0],
                                 p['s5_B_im'][0], p['s5_C_re'][0], p['s5_C_im'][0], init[0], init[1], False)
    ya_b, sb_re, sb_im = s5_scan(ug, p['s5_A_re'][1], p['s5_A_im'][1], p['s5_log_dt'][1], p['s5_B_re'][1],
                                 p['s5_B_im'][1], p['s5_C_re'][1], p['s5_C_im'][1], init[2], init[3], True)

    rkv = centred_conv(rkv, p['rwkv_conv'], rows).astype(f32)
    r, k, v = jnp.split(rkv, 3, axis=-1)
    w_log = p['rwkv_w0'] + jnp.einsum('bldr,drc->bldc', jnp.tanh(wd), p['rwkv_w2'])
    decay = jnp.exp(-jnp.exp(-jax.nn.softplus(-w_log) - 0.5))
    iclr = jax.nn.sigmoid(p['rwkv_a0'] + jnp.einsum('bldr,drc->bldc', ad, p['rwkv_a2']))
    g = jax.nn.sigmoid(gd) @ p['rwkv_g2']

    def heads(t):
        return t.reshape(t.shape[:-1] + (RWKV_HEADS, RWKV_HEAD))

    kk = heads(k * p['rwkv_k_k'])
    kk = kk * lax.rsqrt(jnp.sum(kk * kk, axis=-1, keepdims=True) + 1e-12)
    k_t = heads(k[:, :, None] * (1.0 + (iclr - 1.0) * p['rwkv_k_a']))
    a_h = heads(iclr)
    d_h = heads(decay)
    rh = heads(r)
    vh = heads(v)
    yb_f, S_f = rwkv_scan(rh, d_h[:, :, 0], k_t[:, :, 0], vh, -kk, kk * a_h[:, :, 0], init[4], False)
    yb_b, S_b = rwkv_scan(rh, d_h[:, :, 1], k_t[:, :, 1], vh, -kk, kk * a_h[:, :, 1], init[5], True)
    states = (sf_re, sf_im, sb_re, sb_im, S_f, S_b)
    if not need_out:
        return None, states

    ya = (ya_f + ya_b).reshape(b, n, S5_WIDTH) + p['s5_D'] * u
    ya = jax.nn.gelu(ya)
    ya = ya * jax.nn.sigmoid(ya @ p['s5_w_glu'])

    yb = yb_f + yb_b
    mu = jnp.mean(yb, axis=-1, keepdims=True)
    var = jnp.mean(jnp.square(yb - mu), axis=-1, keepdims=True)
    yb = ((yb - mu) * lax.rsqrt(var + LN_X_EPS)).reshape(b, n, RWKV_WIDTH) * p['rwkv_ln_g'] + p['rwkv_ln_b']
    bonus = jnp.sum(jnp.sum(rh[:, :, None] * k_t * p['rwkv_r_k'], axis=-1, keepdims=True), axis=2) * vh
    yb = yb + bonus.reshape(b, n, RWKV_WIDTH)
    yb = (yb * g) @ p['rwkv_w_o']

    merged = jax.nn.sigmoid(gate_a) * (ya @ p['s5_w_proj']) + jax.nn.sigmoid(gate_b) * yb
    return merged.astype(h.dtype) @ p['w_out'], states


def setup_inputs(seed: int = 0) -> dict:
    key = jax.random.key(seed)
    ks = iter(jax.random.split(key, 48))

    def nrm(shape, scale):
        return scale * jax.random.normal(next(ks), shape, jnp.float32)

    D = D_MODEL
    G, P, GS = S5_GROUPS, S5_STATE, S5_GROUP
    W = RWKV_WIDTH
    x = nrm((BATCH, SEQ, D), 1.0)
    c = nrm((BATCH, D), 1.0)
    ctx = nrm((BATCH, CTX_LEN, D), 1.0)
    c_ctx = nrm((D,), 1.0)
    w_mod = nrm((DEPTH, D, N_MOD * D), 0.5 * D ** -0.5)
    b_mod = nrm((DEPTH, N_MOD * D), 0.01)
    norm_g = 1.0 + nrm((DEPTH, 3, D), 0.02)
    ffn_w_gate = nrm((DEPTH, 2, D, FFN_DIM), D ** -0.5)
    ffn_w_up = nrm((DEPTH, 2, D, FFN_DIM), D ** -0.5)
    ffn_w_down = nrm((DEPTH, 2, FFN_DIM, D), FFN_DIM ** -0.5)
    w_in = nrm((DEPTH, D, IN_COLS), D ** -0.5)
    n_idx = jnp.arange(P, dtype=jnp.float32)
    s5_A_re = -0.5 + nrm((DEPTH, 2, G, P), 0.01)
    s5_A_im = math.pi * n_idx + nrm((DEPTH, 2, G, P), 0.01)
    s5_log_dt = jax.random.uniform(next(ks), (DEPTH, 2, G), jnp.float32, math.log(1e-3), math.log(1e-1))
    s5_B_re = nrm((DEPTH, 2, G, P, GS), (2.0 * GS) ** -0.5)
    s5_B_im = nrm((DEPTH, 2, G, P, GS), (2.0 * GS) ** -0.5)
    s5_C_re = nrm((DEPTH, 2, G, GS, P), P ** -0.5)
    s5_C_im = nrm((DEPTH, 2, G, GS, P), P ** -0.5)
    s5_D = nrm((DEPTH, S5_WIDTH), 1.0)
    s5_w_glu = nrm((DEPTH, S5_WIDTH, S5_WIDTH), S5_WIDTH ** -0.5)
    s5_w_proj = nrm((DEPTH, S5_WIDTH, D), S5_WIDTH ** -0.5)
    rwkv_conv = nrm((DEPTH, CONV_K, CONV_K, 3 * W), 0.1).at[:, 1, 1].add(1.0)
    ramp = jnp.linspace(0.0, 1.0, W, dtype=jnp.float32)
    rwkv_w0 = -6.0 + 7.0 * ramp ** 0.8 + nrm((DEPTH, 2, W), 0.1)
    rwkv_w2 = nrm((DEPTH, 2, DECAY_LORA, W), 0.1 * DECAY_LORA ** -0.5)
    rwkv_a0 = nrm((DEPTH, 2, W), 0.1)
    rwkv_a2 = nrm((DEPTH, 2, AAA_LORA, W), AAA_LORA ** -0.5)
    rwkv_g2 = nrm((DEPTH, GATE_LORA, W), GATE_LORA ** -0.5)
    rwkv_k_k = 0.85 + nrm((DEPTH, W), 0.02)
    rwkv_k_a = 1.0 + nrm((DEPTH, W), 0.02)
    rwkv_r_k = nrm((DEPTH, RWKV_HEADS, RWKV_HEAD), 0.1)
    rwkv_ln_g = 1.0 + nrm((DEPTH, W), 0.02)
    rwkv_ln_b = nrm((DEPTH, W), 0.01)
    rwkv_w_o = nrm((DEPTH, W, D), W ** -0.5)
    w_out = nrm((DEPTH, D, D), D ** -0.5)
    final_g = 1.0 + nrm((D,), 0.02)
    return {'x': x, 'c': c, 'ctx': ctx, 'c_ctx': c_ctx, 'w_mod': w_mod, 'b_mod': b_mod, 'norm_g': norm_g,
            'ffn_w_gate': ffn_w_gate, 'ffn_w_up': ffn_w_up, 'ffn_w_down': ffn_w_down, 'w_in': w_in,
            's5_A_re': s5_A_re, 's5_A_im': s5_A_im, 's5_log_dt': s5_log_dt, 's5_B_re': s5_B_re, 's5_B_im': s5_B_im,
            's5_C_re': s5_C_re, 's5_C_im': s5_C_im, 's5_D': s5_D, 's5_w_glu': s5_w_glu, 's5_w_proj': s5_w_proj,
            'rwkv_conv': rwkv_conv, 'rwkv_w0': rwkv_w0, 'rwkv_w2': rwkv_w2, 'rwkv_a0': rwkv_a0, 'rwkv_a2': rwkv_a2,
            'rwkv_g2': rwkv_g2, 'rwkv_k_k': rwkv_k_k, 'rwkv_k_a': rwkv_k_a, 'rwkv_r_k': rwkv_r_k,
            'rwkv_ln_g': rwkv_ln_g, 'rwkv_ln_b': rwkv_ln_b, 'rwkv_w_o': rwkv_w_o, 'w_out': w_out, 'final_g': final_g}


def reference(x, c, ctx, c_ctx, w_mod, b_mod, norm_g, ffn_w_gate, ffn_w_up, ffn_w_down, w_in,
              s5_A_re, s5_A_im, s5_log_dt, s5_B_re, s5_B_im, s5_C_re, s5_C_im, s5_D, s5_w_glu, s5_w_proj,
              rwkv_conv, rwkv_w0, rwkv_w2, rwkv_a0, rwkv_a2, rwkv_g2, rwkv_k_k, rwkv_k_a, rwkv_r_k,
              rwkv_ln_g, rwkv_ln_b, rwkv_w_o, w_out, final_g):
    b = x.shape[0]
    rows = x.shape[1] // GRID_W
    for l in range(DEPTH):
        need_ctx = l < DEPTH - 1
        mod_x = (jax.nn.silu(c) @ w_mod[l] + b_mod[l]).reshape(b, N_MOD, D_MODEL).transpose(1, 0, 2)[:, :, None, :]
        mod_c = (jax.nn.silu(c_ctx) @ w_mod[l] + b_mod[l]).reshape(N_MOD, 1, 1, D_MODEL)
        p = {'w_in': w_in[l], 's5_A_re': s5_A_re[l], 's5_A_im': s5_A_im[l], 's5_log_dt': s5_log_dt[l],
             's5_B_re': s5_B_re[l], 's5_B_im': s5_B_im[l], 's5_C_re': s5_C_re[l], 's5_C_im': s5_C_im[l],
             's5_D': s5_D[l], 's5_w_glu': s5_w_glu[l], 's5_w_proj': s5_w_proj[l], 'rwkv_conv': rwkv_conv[l],
             'rwkv_w0': rwkv_w0[l], 'rwkv_w2': rwkv_w2[l], 'rwkv_a0': rwkv_a0[l], 'rwkv_a2': rwkv_a2[l],
             'rwkv_g2': rwkv_g2[l], 'rwkv_k_k': rwkv_k_k[l], 'rwkv_k_a': rwkv_k_a[l], 'rwkv_r_k': rwkv_r_k[l],
             'rwkv_ln_g': rwkv_ln_g[l], 'rwkv_ln_b': rwkv_ln_b[l], 'rwkv_w_o': rwkv_w_o[l], 'w_out': w_out[l]}
        x = half_ffn(x, mod_x, 0, norm_g[l, 0], ffn_w_gate[l, 0], ffn_w_up[l, 0], ffn_w_down[l, 0])
        ctx = half_ffn(ctx, mod_c, 0, norm_g[l, 0], ffn_w_gate[l, 0], ffn_w_up[l, 0], ffn_w_down[l, 0])
        hc = modulate(ctx, norm_g[l, 1], mod_c[3], mod_c[4])
        hx = modulate(x, norm_g[l, 1], mod_x[3], mod_x[4])
        out_c, ctx_states = token_mixers(hc, 1, zero_states(ctx.shape[0]), p, need_ctx)
        out_x, _ = token_mixers(hx, rows, ctx_states, p, True)
        x = x + mod_x[5] * out_x
        x = half_ffn(x, mod_x, 2, norm_g[l, 2], ffn_w_gate[l, 1], ffn_w_up[l, 1], ffn_w_down[l, 1])
        if need_ctx:
            ctx = ctx + mod_c[5] * out_c
            ctx = half_ffn(ctx, mod_c, 2, norm_g[l, 2], ffn_w_gate[l, 1], ffn_w_up[l, 1], ffn_w_down[l, 1])
    return rmsnorm(x, final_g)
```

```cpp
#include <hip/hip_runtime.h>
#include <hip/hip_cooperative_groups.h>
#include <cstdio>
#include <cstdint>
namespace cg = cooperative_groups;

namespace pg8 {
#define PG8_LAS __attribute__((address_space(3)))
typedef unsigned short bf16_t;
typedef short bf16x8 __attribute__((ext_vector_type(8)));
typedef float f32x4 __attribute__((ext_vector_type(4)));
typedef unsigned u32x4 __attribute__((ext_vector_type(4)));
typedef unsigned u32x2 __attribute__((ext_vector_type(2)));
constexpr int BM = 256, BK = 64, HALF = 128, HTB = HALF * BK * 2, STAGE_BYTES = 8 * HTB, NXCD = 8, WGM = 8;

__host__ __device__ __forceinline__ int lds_byte(int r, int c) { const int st = (r >> 4) * 2 + (c >> 5), rr = r & 15, cc = c & 31, ob = rr * 64 + cc * 2; return st * 1024 + (ob ^ (((ob >> 9) & 1) << 5)); }
__host__ __device__ __forceinline__ void stage_rc(int b, int& R, int& C) { const int st = b / 1024, sb = b % 1024, swz = sb ^ (((sb >> 9) & 1) << 5); R = (st >> 1) * 16 + swz / 64; C = (st & 1) * 32 + (swz % 64) / 2; }
__host__ __device__ __forceinline__ int perm32(int rho) { const int n = rho >> 4, i = rho & 15; return 8 * (i >> 2) + 4 * n + (i & 3); }

struct Unit { int pm, pn; };
struct Gemm { const bf16_t* A; const bf16_t* Bt; int M, N, K; };

struct StaticOrder {
    int nM, nN, nwg, G, c;
    __host__ __device__ void init(int M, int N, int G_, int c_) { nM = M / BM; nN = N / BM; nwg = nM * nN; G = G_; c = c_; }
    __host__ __device__ bool next(int i, Unit& u) const {
        const long L = (long)i * G + c; if (L >= nwg) return false;
        int wgid = (int)L; { const int q = nwg / NXCD, r = nwg % NXCD, xcd = wgid % NXCD, off = wgid / NXCD; wgid = (xcd < r ? xcd * (q + 1) : r * (q + 1) + (xcd - r) * q) + off; }
        const int nig = WGM * nN, gid = wgid / nig, fm = gid * WGM, gsz = (nM - fm) < WGM ? (nM - fm) : WGM;
        u.pm = fm + ((wgid % nig) % gsz); u.pn = (wgid % nig) / gsz; return true;
    }
    __device__ __forceinline__ void a_ready(const Unit&) const {}
    __device__ __forceinline__ void done(const Unit&) const {}
};

template <class Epi, class Sched>
__device__ __forceinline__ void gemm_phase(PG8_LAS unsigned char* lds, const Gemm g, const Sched& S, const Epi& E) {
    int tid_ = threadIdx.x; asm volatile("" : "+v"(tid_));
    const int tid = tid_, wid = __builtin_amdgcn_readfirstlane(tid >> 6), lane = tid & 63, wr = wid >> 2, wc = wid & 3, fr = lane & 15, fq = lane >> 4;
    const int K = g.K, nt = K / BK;
    unsigned voffA[2], voffB[2];
#pragma unroll
    for (int i = 0; i < 2; ++i) { int R, C; stage_rc(tid * 16 + i * 8192, R, C); const int Rb = Epi::PERM ? ((R & ~31) + perm32(R & 31)) : R;
        voffA[i] = (unsigned)(R * K + C) * 2u; voffB[i] = (unsigned)(Rb * K + C) * 2u; }
    const size_t kstep = (size_t)(BK * 2);
    const size_t hstep = (size_t)HALF * K * 2;
    const size_t tstep = 2 * hstep;
    const unsigned ldsw = (unsigned)wid * 1024u;
    const int aoff = lds_byte(wr * 64 + fr, fq * 8), boff = lds_byte(wc * 32 + fr, fq * 8);
#define PG8_SA(b, h) (((b) * 2 + (h)) * HTB)
#define PG8_SB(b, h) ((4 + (b) * 2 + (h)) * HTB)
#define PG8_STAGE(bufoff, gbase, voff) do { _Pragma("unroll") for (int _i = 0; _i < 2; ++_i) \
        __builtin_amdgcn_global_load_lds((const unsigned*)((const char*)(gbase) + (voff)[_i]), (PG8_LAS unsigned*)(lds + (bufoff) + ldsw + _i * 8192), 16, 0, 0); } while (0)
#define PG8_LDA(dst, b, h) do { _Pragma("unroll") for (int m = 0; m < 4; ++m) _Pragma("unroll") for (int k = 0; k < 2; ++k) dst[m][k] = *(const PG8_LAS bf16x8*)(lds + PG8_SA(b, h) + aoff + m * 2048 + k * 1024); } while (0)
#define PG8_LDB(dst, b, h) do { _Pragma("unroll") for (int n = 0; n < 2; ++n) _Pragma("unroll") for (int k = 0; k < 2; ++k) dst[n][k] = *(const PG8_LAS bf16x8*)(lds + PG8_SB(b, h) + boff + n * 2048 + k * 1024); } while (0)
#define PG8_MMA(ai, bj, At, Bt) do { __builtin_amdgcn_s_setprio(1); _Pragma("unroll") for (int m = 0; m < 4; ++m) _Pragma("unroll") for (int n = 0; n < 2; ++n) _Pragma("unroll") for (int k = 0; k < 2; ++k) \
        acc[ai][bj][m][n] = __builtin_amdgcn_mfma_f32_16x16x32_bf16(Bt[n][k], At[m][k], acc[ai][bj][m][n], 0, 0, 0); __builtin_amdgcn_s_setprio(0); } while (0)
#define PG8_WAIT_V(n) asm volatile("s_waitcnt vmcnt(" #n ")" ::: "memory")
#define PG8_WAIT_L(n) asm volatile("s_waitcnt lgkmcnt(" #n ")" ::: "memory")
#define PG8_BAR __builtin_amdgcn_s_barrier()
#define PG8_SCHED __builtin_amdgcn_sched_barrier(0)
    Unit cur, nxt; int ui = 0;
    if (!S.next(0, cur)) return;
    f32x4 acc[2][2][4][2];
#pragma unroll
    for (int a = 0; a < 2; ++a)
#pragma unroll
        for (int b = 0; b < 2; ++b)
#pragma unroll
            for (int m = 0; m < 4; ++m)
#pragma unroll
                for (int n = 0; n < 2; ++n) acc[a][b][m][n] = (f32x4){0.f, 0.f, 0.f, 0.f};
    bf16x8 At[4][2], B0[2][2], B1[2][2];
    const char* cA = (const char*)g.A + (size_t)cur.pm * tstep; const char* cB = (const char*)g.Bt + (size_t)cur.pn * tstep;
    S.a_ready(cur);
    PG8_STAGE(PG8_SB(0, 0), cB, voffB); PG8_STAGE(PG8_SA(0, 0), cA, voffA); PG8_STAGE(PG8_SB(0, 1), cB + hstep, voffB); PG8_STAGE(PG8_SA(0, 1), cA + hstep, voffA);
    if (wr == 1) PG8_BAR;
    PG8_WAIT_V(4); PG8_BAR;
    PG8_STAGE(PG8_SB(1, 0), cB + kstep, voffB); PG8_STAGE(PG8_SA(1, 0), cA + kstep, voffA); PG8_STAGE(PG8_SB(1, 1), cB + hstep + kstep, voffB);
    PG8_WAIT_V(6); PG8_BAR;
    for (;;) {
        const bool has_next = S.next(ui + 1, nxt);
        const char* nA = has_next ? (const char*)g.A + (size_t)nxt.pm * tstep : cA; const char* nB = has_next ? (const char*)g.Bt + (size_t)nxt.pn * tstep : cB;
        for (int t = 0; t < nt; t += 2) {
            const bool last = (t == nt - 2);
            const char* a1 = cA + (size_t)(t + 1) * kstep;
            const char* a2 = last ? nA : cA + (size_t)(t + 2) * kstep; const char* b2 = last ? nB : cB + (size_t)(t + 2) * kstep;
            const char* a3 = a2 + kstep; const char* b3 = b2 + kstep;
            if (last && has_next) S.a_ready(nxt);
            PG8_LDB(B0, 0, 0); PG8_SCHED; PG8_LDA(At, 0, 0); PG8_STAGE(PG8_SA(1, 1), a1 + hstep, voffA);
            PG8_WAIT_L(8); PG8_BAR; PG8_WAIT_L(0); PG8_MMA(0, 0, At, B0); PG8_BAR; PG8_SCHED;
            PG8_LDB(B1, 0, 1); PG8_STAGE(PG8_SB(0, 0), b2, voffB);
            PG8_BAR; PG8_WAIT_L(0); PG8_MMA(0, 1, At, B1); PG8_BAR;
            PG8_LDA(At, 0, 1); PG8_STAGE(PG8_SA(0, 0), a2, voffA);
            PG8_BAR; PG8_WAIT_L(0); PG8_MMA(1, 0, At, B0); PG8_BAR; PG8_SCHED;
            PG8_STAGE(PG8_SB(0, 1), b2 + hstep, voffB);
            PG8_WAIT_V(6); PG8_BAR; PG8_MMA(1, 1, At, B1); PG8_BAR;
            PG8_LDB(B0, 1, 0); PG8_SCHED; PG8_LDA(At, 1, 0); PG8_STAGE(PG8_SA(0, 1), a2 + hstep, voffA);
            PG8_WAIT_L(8); PG8_BAR; PG8_WAIT_L(0); PG8_MMA(0, 0, At, B0); PG8_BAR; PG8_SCHED;
            PG8_LDB(B1, 1, 1); PG8_STAGE(PG8_SB(1, 0), b3, voffB);
            PG8_BAR; PG8_WAIT_L(0); PG8_MMA(0, 1, At, B1); PG8_BAR;
            PG8_LDA(At, 1, 1); PG8_STAGE(PG8_SA(1, 0), a3, voffA);
            PG8_BAR; PG8_WAIT_L(0); PG8_MMA(1, 0, At, B0); PG8_BAR; PG8_SCHED;
            PG8_STAGE(PG8_SB(1, 1), b3 + hstep, voffB);
            PG8_WAIT_V(6); PG8_BAR; PG8_MMA(1, 1, At, B1); PG8_BAR;
        }
        E(acc, cur, wr, wc, fr, fq); S.done(cur);
        if (!has_next) break;
#pragma unroll
        for (int a = 0; a < 2; ++a)
#pragma unroll
            for (int b = 0; b < 2; ++b)
#pragma unroll
                for (int m = 0; m < 4; ++m)
#pragma unroll
                    for (int n = 0; n < 2; ++n) acc[a][b][m][n] = (f32x4){0.f, 0.f, 0.f, 0.f};
        cur = nxt; cA = nA; cB = nB; ++ui;
    }
    PG8_WAIT_V(0);
    if (wr == 0) PG8_BAR;
    PG8_BAR;
#undef PG8_SA
#undef PG8_SB
#undef PG8_STAGE
#undef PG8_LDA
#undef PG8_LDB
#undef PG8_MMA
#undef PG8_WAIT_V
#undef PG8_WAIT_L
#undef PG8_BAR
#undef PG8_SCHED
}
}

using pg8::bf16_t; using pg8::f32x4; using pg8::u32x4; using pg8::u32x2; using pg8::bf16x8; using pg8::Unit;
typedef float f32x2 __attribute__((ext_vector_type(2)));

constexpr int D = 1024, NB = 8, SEQ = 4096, CTXL = 256, FF = 2816;
constexpr int TX = NB * SEQ, TC = NB * CTXL, TT = TX + TC;
constexpr int NMODC = 9 * D;
constexpr int INC = 4480;
constexpr int NTHR = 512;
constexpr int LDS_BYTES = 131072 + 256;

constexpr size_t OFF_MOD = 4096;
constexpr size_t OFF_S5A = OFF_MOD + (size_t)9 * NMODC * 4;
constexpr size_t OFF_S5B = OFF_S5A + 2 * 32 * 64 * 2 * 4;
constexpr size_t OFF_S5C = OFF_S5B + 2 * 32 * 128 * 16 * 2;
constexpr size_t OFF_KN  = OFF_S5C + 2 * 32 * 16 * 128 * 2;
constexpr size_t OFF_BAR = OFF_KN + (size_t)34816 * 8 * 4;
constexpr size_t OFF_W   = 2097152;
static_assert(OFF_BAR + 3456 * 4 <= OFF_W, "ws");
constexpr size_t SZ_WGU = (size_t)2 * FF * D * 2, SZ_WD = (size_t)D * FF * 2;
constexpr size_t OFF_WGU1 = OFF_W, OFF_WGU2 = OFF_WGU1 + SZ_WGU, OFF_WD1 = OFF_WGU2 + SZ_WGU, OFF_WD2 = OFF_WD1 + SZ_WD;
constexpr size_t OFF_WIN1 = OFF_WD2 + SZ_WD;
constexpr size_t OFF_WGATE = OFF_WIN1 + (size_t)2560 * D * 2;
constexpr size_t OFF_WGLU = OFF_WGATE + (size_t)2048 * D * 2;
constexpr size_t OFF_WPROJ = OFF_WGLU + (size_t)512 * 512 * 2;
constexpr size_t OFF_WO = OFF_WPROJ + (size_t)1024 * 512 * 2;
constexpr size_t OFF_WOUT = OFF_WO + (size_t)1024 * 512 * 2;
constexpr size_t OFF_WLORA = OFF_WOUT + (size_t)1024 * 1024 * 2;
constexpr size_t OFF_XC1 = OFF_WLORA + (size_t)2560 * 384 * 2;
constexpr size_t ARENA = OFF_XC1 + (size_t)TC * D * 4;
constexpr size_t A_R0 = ARENA;
constexpr size_t A_LW = A_R0 + (size_t)TT * D * 2;
constexpr size_t A_U = A_LW + (size_t)TT * D * 2;
constexpr size_t A_RKV = A_U + (size_t)TT * 512 * 2;
constexpr size_t A_G = A_RKV + (size_t)TT * 1536 * 2;
constexpr size_t A_TAIL = A_G + (size_t)TX * 512 * 2;
constexpr size_t A_LA = A_TAIL + (size_t)TT * 1536 * 2;
constexpr size_t A_ACT = A_LW;
constexpr size_t WS_NEED = 536870912;
static_assert(A_TAIL + (size_t)TX * 2048 * 2 <= WS_NEED, "ws");
static_assert(A_LA + (size_t)TT * 384 * 2 <= WS_NEED, "ws");
static_assert(A_ACT + (size_t)TT * FF * 2 <= WS_NEED, "ws");
static_assert(OFF_KN + (size_t)TT * 8 * 4 <= OFF_W, "ws");

struct Params {
    const float *x, *c, *ctx, *c_ctx, *w_mod, *b_mod, *norm_g, *w_gate, *w_up, *w_down, *w_in;
    const float *s5_A_re, *s5_A_im, *s5_log_dt, *s5_B_re, *s5_B_im, *s5_C_re, *s5_C_im, *s5_D, *s5_w_glu, *s5_w_proj;
    const float *rwkv_conv, *rwkv_w0, *rwkv_w2, *rwkv_a0, *rwkv_a2, *rwkv_g2, *rwkv_k_k, *rwkv_k_a, *rwkv_r_k, *rwkv_ln_g, *rwkv_ln_b, *rwkv_w_o, *w_out, *final_g;
    float* out; unsigned char* ws;
};

typedef const __attribute__((address_space(4))) Params* KP;
#define KP_LAUNDER(dst, srcp) KP dst = (srcp); asm volatile("" : "+s"(dst))

__device__ __forceinline__ int tid_l() { int t = threadIdx.x; asm volatile("" : "+v"(t)); return t; }
__device__ __forceinline__ int bid_l() { int t = blockIdx.x; asm volatile("" : "+s"(t)); return t; }
__device__ __forceinline__ float bf2f(unsigned v) { return __uint_as_float(v << 16); }
__device__ __forceinline__ unsigned f2bf(float f) { unsigned u = __float_as_uint(f); return (u + 0x7fffu + ((u >> 16) & 1u)) >> 16; }
typedef __bf16 bf16x2_hw __attribute__((ext_vector_type(2)));
__device__ __forceinline__ unsigned pk2(float lo, float hi) { const f32x2 v = (f32x2){lo, hi}; return __builtin_bit_cast(unsigned, __builtin_convertvector(v, bf16x2_hw)); }
__device__ __forceinline__ float bflo(unsigned w) { return __uint_as_float(w << 16); }
__device__ __forceinline__ float bfhi(unsigned w) { return __uint_as_float(w & 0xffff0000u); }
__device__ __forceinline__ float sigmoidf_(float x) { return __builtin_amdgcn_rcpf(1.0f + __expf(-x)); }
__device__ __forceinline__ float tanhf_(float x) { const float e = __expf(2.0f * x); return 1.0f - 2.0f * __builtin_amdgcn_rcpf(e + 1.0f); }
__device__ __forceinline__ float siluf_(float x) { return x * __builtin_amdgcn_rcpf(1.0f + __expf(-x)); }
__device__ __forceinline__ float geluf_(float x) { const float u = 0.7978845608f * (x + 0.044715f * x * x * x); return 0.5f * x * (1.0f + tanhf_(u)); }
__device__ __forceinline__ void unpack8(const u32x4 w, float* f) { f[0] = bflo(w.x); f[1] = bfhi(w.x); f[2] = bflo(w.y); f[3] = bfhi(w.y); f[4] = bflo(w.z); f[5] = bfhi(w.z); f[6] = bflo(w.w); f[7] = bfhi(w.w); }
__device__ __forceinline__ u32x4 pack8(const float* f) { u32x4 w; w.x = pk2(f[0], f[1]); w.y = pk2(f[2], f[3]); w.z = pk2(f[4], f[5]); w.w = pk2(f[6], f[7]); return w; }
__device__ __forceinline__ float wave_sum(float v) {
#pragma unroll
    for (int o = 32; o >= 1; o >>= 1) v += __shfl_xor(v, o);
    return v;
}
template <int CTRL> __device__ __forceinline__ float dpp_f(float v) { return __int_as_float(__builtin_amdgcn_update_dpp(0, __float_as_int(v), CTRL, 0xF, 0xF, true)); }
__device__ __forceinline__ float sum16(float v) {
    v += dpp_f<0xB1>(v);
    v += dpp_f<0x4E>(v);
    v += dpp_f<0x141>(v);
    v += dpp_f<0x140>(v);
    return v;
}
__device__ __forceinline__ float sum8(float v) {
    v += dpp_f<0xB1>(v);
    v += dpp_f<0x4E>(v);
    v += dpp_f<0x141>(v);
    return v;
}


#define LAS __attribute__((address_space(3)))
#define XB_TMO      128
#define XB_XCNT(j)  (256  + 64 * (j))
#define XB_XSUB(j)  (1280 + 64 * (j))
#define XB_XGEN(j)  (2304 + 64 * (j))
#define XB_TOP      3328
#define XB_TOPGEN   3392
#define XCD_BAR_WORDS 3456
#define XB_SPIN_CAP (1u << 18)
__device__ __forceinline__ unsigned xb_ld(unsigned* p)              { return __hip_atomic_load(p, __ATOMIC_RELAXED, __HIP_MEMORY_SCOPE_AGENT); }
__device__ __forceinline__ unsigned xb_add(unsigned* p, unsigned v) { return __hip_atomic_fetch_add(p, v, __ATOMIC_RELAXED, __HIP_MEMORY_SCOPE_AGENT); }
__device__ __forceinline__ unsigned xb_xcc_id() { return (unsigned)__builtin_amdgcn_s_getreg((3 << 11) | 20) & 0xFu; }
#define XB_SPIN(cond, bar) do { unsigned _sp = 0; while (cond) { __builtin_amdgcn_s_sleep(1); \
    if ((++_sp & 255u) == 0u) { if (xb_ld(&(bar)[XB_TMO])) break; if (_sp > XB_SPIN_CAP) { atomicAdd(&(bar)[XB_TMO], 1u); break; } } } } while (0)
struct XcdBarrier { unsigned* bar; unsigned x; volatile LAS unsigned* st; };
__device__ __forceinline__ XcdBarrier xcd_barrier_post(unsigned* bar, volatile LAS unsigned* st) {
    XcdBarrier b; b.bar = bar; b.x = xb_xcc_id(); b.st = st;
    if (threadIdx.x == 0) (void)xb_add(&bar[XB_XCNT(b.x)], 1u);
    return b;
}
__device__ __forceinline__ void xcd_barrier_complete(unsigned* bar, unsigned x, unsigned& nloc, unsigned& nx) {
    const unsigned G = gridDim.x * gridDim.y * gridDim.z;
    unsigned sum, cnt, mine, sp = 0u;
    for (;;) {
        sum = 0u; cnt = 0u; mine = 0u;
#pragma unroll
        for (unsigned j = 0; j < 16; ++j) { const unsigned c = xb_ld(&bar[XB_XCNT(j)]); sum += c; cnt += (c > 0u) ? 1u : 0u; mine = (j == x) ? c : mine; }
        if (sum == G) break;
        __builtin_amdgcn_s_sleep(1);
        if ((++sp & 255u) == 0u) { if (xb_ld(&bar[XB_TMO])) break; if (sp > XB_SPIN_CAP) { atomicAdd(&bar[XB_TMO], 1u); break; } }
    }
    nloc = mine > 0u ? mine : 1u; nx = cnt > 0u ? cnt : 1u;
}
__device__ __forceinline__ void xcd_barrier(const XcdBarrier& b) {
    asm volatile("s_waitcnt vmcnt(0)" ::: "memory");
    __syncthreads();
    if (threadIdx.x == 0) {
        unsigned* bar = b.bar;
        __builtin_amdgcn_s_waitcnt(0);
        unsigned nloc = b.st[0], nx = b.st[1];
        if (nloc == 0u) { xcd_barrier_complete(bar, b.x, nloc, nx); b.st[0] = nloc; b.st[1] = nx; }
        const unsigned old = xb_add(&bar[XB_XSUB(b.x)], 1u);
        const unsigned gen = old / nloc;
        if (old + 1u == (gen + 1u) * nloc) {
            __builtin_amdgcn_fence(__ATOMIC_RELEASE, "agent");
            asm volatile("s_waitcnt vmcnt(0)" ::: "memory");
            const unsigned og = xb_add(&bar[XB_TOP], 1u);
            const unsigned tg = og / nx;
            if (og + 1u == (tg + 1u) * nx) xb_add(&bar[XB_TOPGEN], 1u);
            else XB_SPIN(xb_ld(&bar[XB_TOPGEN]) == tg, bar);
            __builtin_amdgcn_fence(__ATOMIC_ACQUIRE, "agent");
            xb_add(&bar[XB_XGEN(b.x)], 1u);
            asm volatile("s_waitcnt vmcnt(0)" ::: "memory");
        } else {
            XB_SPIN(xb_ld(&bar[XB_XGEN(b.x)]) == gen, bar);
            __builtin_amdgcn_fence(__ATOMIC_ACQUIRE, "agent");
            asm volatile("s_waitcnt vmcnt(0)" ::: "memory");
        }
    }
    __syncthreads();
}

struct EpiGU {
    static constexpr bool PERM = true;
    bf16_t* O;
    __device__ __forceinline__ void operator()(f32x4 (&acc)[2][2][4][2], const Unit& u, int wr, int wc, int fr, int fq) const {
        asm volatile("" : "+v"(fr), "+v"(fq));
        const int row0 = u.pm * 256 + wr * 64 + fr, col0 = (u.pn * 256 + wc * 32 + 8 * fq) >> 1;
#pragma unroll
        for (int ai = 0; ai < 2; ++ai)
#pragma unroll
            for (int m = 0; m < 4; ++m) { bf16_t* rowp = O + (size_t)(row0 + ai * 128 + m * 16) * FF + col0;
#pragma unroll
                for (int bj = 0; bj < 2; ++bj) { const f32x4 g = acc[ai][bj][m][0], up = acc[ai][bj][m][1];
                    u32x2 w; w.x = pk2(siluf_(g[0]) * up[0], siluf_(g[1]) * up[1]); w.y = pk2(siluf_(g[2]) * up[2], siluf_(g[3]) * up[3]);
                    *(u32x2*)(rowp + bj * 64) = w; } }
    }
};
struct EpiRes {
    static constexpr bool PERM = false;
    const float* srcx; float* dstx; const float* srcc; float* dstc; const float* mod; float scale;
    __device__ __forceinline__ void operator()(f32x4 (&acc)[2][2][4][2], const Unit& u, int wr, int wc, int fr, int fq) const {
        asm volatile("" : "+v"(fr), "+v"(fq));
        const int rowt = u.pm * 256; const bool isx = rowt < TX;
        const int bi = isx ? (rowt >> 12) : 8;
        const float* src = isx ? srcx : srcc - (size_t)TX * D; float* dst = isx ? dstx : dstc - (size_t)TX * D;
        const int row0 = rowt + wr * 64 + fr, col0 = u.pn * 256 + wc * 32 + 4 * fq;
#pragma unroll
        for (int bj = 0; bj < 2; ++bj)
#pragma unroll
            for (int n = 0; n < 2; ++n) { const f32x4 mv = *(const f32x4*)(mod + (size_t)bi * NMODC + col0 + bj * 128 + n * 16) * scale;
#pragma unroll
                for (int ai = 0; ai < 2; ++ai)
#pragma unroll
                    for (int m = 0; m < 4; ++m) acc[ai][bj][m][n] *= mv; }
        f32x4 cur[4], nxt[4];
#pragma unroll
        for (int q = 0; q < 4; ++q) cur[q] = *(const f32x4*)(src + (size_t)row0 * D + col0 + (q >> 1) * 128 + (q & 1) * 16);
#pragma unroll
        for (int g = 0; g < 8; ++g) {
            const int ai = g >> 2, m = g & 3;
            if (g < 7) { const size_t rn = (size_t)(row0 + ((g + 1) >> 2) * 128 + ((g + 1) & 3) * 16) * D + col0;
#pragma unroll
                for (int q = 0; q < 4; ++q) nxt[q] = *(const f32x4*)(src + rn + (q >> 1) * 128 + (q & 1) * 16); }
            const size_t ro = (size_t)(row0 + ai * 128 + m * 16) * D + col0;
#pragma unroll
            for (int q = 0; q < 4; ++q) *(f32x4*)(dst + ro + (q >> 1) * 128 + (q & 1) * 16) = cur[q] + acc[ai][q >> 1][m][q & 1];
#pragma unroll
            for (int q = 0; q < 4; ++q) cur[q] = nxt[q];
        }
    }
};
struct EpiIn {
    static constexpr bool PERM = true;
    bf16_t *U, *RKVP, *LA;
    __device__ __forceinline__ void operator()(f32x4 (&acc)[2][2][4][2], const Unit& u, int wr, int wc, int fr, int fq) const {
        asm volatile("" : "+v"(fr), "+v"(fq));
        const int row0 = u.pm * 256 + wr * 64 + fr;
#pragma unroll
        for (int bj = 0; bj < 2; ++bj) {
            const int c0 = u.pn * 256 + bj * 128 + wc * 32 + 8 * fq;
            if (c0 >= 2432) continue;
            bf16_t* base; int ld, cc, act = 0;
            if (c0 < 512) { base = U; ld = 512; cc = c0; }
            else if (c0 < 2048) { base = RKVP; ld = 1536; cc = c0 - 512; }
            else { base = LA; ld = 384; cc = c0 - 2048; act = (cc < 128) ? 1 : (cc < 256 ? 0 : 2); }
#pragma unroll
            for (int ai = 0; ai < 2; ++ai)
#pragma unroll
                for (int m = 0; m < 4; ++m) {
                    float v[8];
#pragma unroll
                    for (int j = 0; j < 4; ++j) { v[j] = acc[ai][bj][m][0][j]; v[4 + j] = acc[ai][bj][m][1][j]; }
                    if (act == 1) {
#pragma unroll
                        for (int j = 0; j < 8; ++j) v[j] = tanhf_(v[j]);
                    } else if (act == 2) {
#pragma unroll
                        for (int j = 0; j < 8; ++j) v[j] = sigmoidf_(v[j]);
                    }
                    *(u32x4*)(base + (size_t)(row0 + ai * 128 + m * 16) * ld + cc) = pack8(v);
                }
        }
    }
};
struct EpiLora {
    static constexpr bool PERM = true;
    unsigned char* wsb; const float *w0, *a0;
    __device__ __forceinline__ void operator()(f32x4 (&acc)[2][2][4][2], const Unit& u, int wr, int wc, int fr, int fq) const {
        asm volatile("" : "+v"(fr), "+v"(fq));
        const int seg = u.pn >> 2;
        if (seg == 2 && u.pm * 256 >= TX) return;
        const size_t boff = (size_t)(seg == 0) * A_LW + (size_t)(seg == 1) * A_R0 + (size_t)(seg == 2) * A_G;
        bf16_t* base = (bf16_t*)(wsb + boff);
        const int ld = seg == 2 ? 512 : 1024;
        const float* bp = w0 + (seg == 1 ? (a0 - w0) : (ptrdiff_t)0);
        const float mul = seg == 0 ? -0.6065306597f : 1.0f;
        const int row0 = u.pm * 256 + wr * 64 + fr;
#pragma unroll
        for (int bj = 0; bj < 2; ++bj) {
            const int cc = (u.pn & 3) * 256 + bj * 128 + wc * 32 + 8 * fq;
            float bias[8];
#pragma unroll
            for (int j = 0; j < 8; ++j) bias[j] = (seg == 2) ? 0.f : bp[cc + j];
#pragma unroll
            for (int ai = 0; ai < 2; ++ai)
#pragma unroll
                for (int m = 0; m < 4; ++m) {
                    float v[8];
#pragma unroll
                    for (int j = 0; j < 4; ++j) { v[j] = acc[ai][bj][m][0][j]; v[4 + j] = acc[ai][bj][m][1][j]; }
                    if (seg != 2) {
#pragma unroll
                        for (int j = 0; j < 8; ++j) v[j] = mul * sigmoidf_(v[j] + bias[j]);
                    }
                    *(u32x4*)(base + (size_t)(row0 + ai * 128 + m * 16) * ld + cc) = pack8(v);
                }
        }
    }
};
template <int MODE> struct EpiBf {
    static constexpr bool PERM = true;
    bf16_t* O; int ld; const bf16_t* aux; int ldaux;
    __device__ __forceinline__ void operator()(f32x4 (&acc)[2][2][4][2], const Unit& u, int wr, int wc, int fr, int fq) const {
        asm volatile("" : "+v"(fr), "+v"(fq));
        const int row0 = u.pm * 256 + wr * 64 + fr, col0 = u.pn * 256 + wc * 32 + 8 * fq;
        const int auxc = (MODE == 3) ? 1024 + col0 : col0;
        u32x4 ca[2], co[2], na[2], no[2];
        if (MODE >= 1) {
#pragma unroll
            for (int bj = 0; bj < 2; ++bj) { ca[bj] = *(const u32x4*)(aux + (size_t)row0 * ldaux + auxc + bj * 128);
                if (MODE == 3) co[bj] = *(const u32x4*)(O + (size_t)row0 * ld + col0 + bj * 128); }
        }
#pragma unroll
        for (int g = 0; g < 8; ++g) {
            const int ai = g >> 2, m = g & 3;
            const size_t row = (size_t)(row0 + ai * 128 + m * 16);
            if (MODE >= 1 && g < 7) { const size_t rn = (size_t)(row0 + ((g + 1) >> 2) * 128 + ((g + 1) & 3) * 16);
#pragma unroll
                for (int bj = 0; bj < 2; ++bj) { na[bj] = *(const u32x4*)(aux + rn * ldaux + auxc + bj * 128);
                    if (MODE == 3) no[bj] = *(const u32x4*)(O + rn * ld + col0 + bj * 128); } }
#pragma unroll
            for (int bj = 0; bj < 2; ++bj) {
                float v[8];
#pragma unroll
                for (int j = 0; j < 4; ++j) { v[j] = acc[ai][bj][m][0][j]; v[4 + j] = acc[ai][bj][m][1][j]; }
                if (MODE == 0) {
#pragma unroll
                    for (int j = 0; j < 8; ++j) v[j] = sigmoidf_(v[j]);
                } else if (MODE == 1) {
                    float a[8]; unpack8(ca[bj], a);
#pragma unroll
                    for (int j = 0; j < 8; ++j) v[j] = a[j] * sigmoidf_(v[j]);
                } else if (MODE == 2) {
                    float a[8]; unpack8(ca[bj], a);
#pragma unroll
                    for (int j = 0; j < 8; ++j) v[j] = a[j] * v[j];
                } else {
                    float a[8], o[8]; unpack8(ca[bj], a); unpack8(co[bj], o);
#pragma unroll
                    for (int j = 0; j < 8; ++j) v[j] = o[j] + a[j] * v[j];
                }
                *(u32x4*)(O + row * ld + col0 + bj * 128) = pack8(v);
            }
            if (MODE >= 1) {
#pragma unroll
                for (int bj = 0; bj < 2; ++bj) { ca[bj] = na[bj]; if (MODE == 3) co[bj] = no[bj]; }
            }
        }
    }
};

template <class Epi>
__device__ __forceinline__ void run_gemm(unsigned char* smem, const bf16_t* A, const bf16_t* Bt, int M, int N, int K, const Epi& E) {
    pg8::Gemm g; g.A = A; g.Bt = Bt; g.M = M; g.N = N; g.K = K;
    pg8::StaticOrder S; S.init(M, N, gridDim.x, bid_l());
    pg8::gemm_phase<Epi, pg8::StaticOrder>((PG8_LAS unsigned char*)smem, g, S, E);
}

__device__ __forceinline__ void tconv_job(unsigned char* smem, const float* src, int K, int ldsrc, int c0, int ncols, bf16_t* dst, int mode, int& base) {
    float* tile = (float*)smem;
    const int G = gridDim.x, bid = bid_l(), tid = tid_l();
    const int ntn = ncols / 64, ntk = K / 64, ntiles = ntn * ntk;
    int t = (bid - (base % G) + G) % G;
    for (; t < ntiles; t += G) {
        const int tk = t / ntn, tn = t % ntn, k0 = tk * 64, n0 = tn * 64;
        {
            const int r = tid >> 4, c4 = tid & 15;
#pragma unroll
            for (int i = 0; i < 2; ++i) {
                const f32x4 v = *(const f32x4*)(src + (size_t)(k0 + r + 32 * i) * ldsrc + c0 + n0 + 4 * c4);
                float* tp = tile + (r + 32 * i) * 65 + 4 * c4; tp[0] = v[0]; tp[1] = v[1]; tp[2] = v[2]; tp[3] = v[3];
            }
        }
        __syncthreads();
        {
            const int n = tid >> 3, k8 = tid & 7;
            float v[8];
#pragma unroll
            for (int j = 0; j < 8; ++j) v[j] = tile[(8 * k8 + j) * 65 + n];
            const int ng = n0 + n;
            const int row = (mode == 0) ? ng : ((ng >> 2) * 8 + (ng & 3) + (mode == 2 ? 4 : 0));
            *(u32x4*)(dst + (size_t)row * K + k0 + 8 * k8) = pack8(v);
        }
        __syncthreads();
    }
    base += ntiles;
}

__device__ __forceinline__ void phase0(KP kp_, unsigned char* smem) {
    KP_LAUNDER(kp, kp_);
    unsigned char* ws = kp->ws;
    const int G = gridDim.x, bid = bid_l(), tid = tid_l();
    const int gtid = bid * NTHR + tid, gthreads = G * NTHR;
    int base = 0;
    for (int l = 0; l < 2; ++l) {
        bf16_t* wgu = (bf16_t*)(ws + (l == 0 ? OFF_WGU1 : OFF_WGU2));
        tconv_job(smem, kp->w_gate + (size_t)l * D * FF, D, FF, 0, FF, wgu, 1, base);
        tconv_job(smem, kp->w_up + (size_t)l * D * FF, D, FF, 0, FF, wgu, 2, base);
        tconv_job(smem, kp->w_down + (size_t)l * FF * D, FF, D, 0, D, (bf16_t*)(ws + (l == 0 ? OFF_WD1 : OFF_WD2)), 0, base);
    }
    tconv_job(smem, kp->w_in, D, INC, 0, 2432, (bf16_t*)(ws + OFF_WIN1), 0, base);
    tconv_job(smem, kp->w_in, D, INC, 2432, 2048, (bf16_t*)(ws + OFF_WGATE), 0, base);
    tconv_job(smem, kp->s5_w_glu, 512, 512, 0, 512, (bf16_t*)(ws + OFF_WGLU), 0, base);
    tconv_job(smem, kp->s5_w_proj, 512, D, 0, D, (bf16_t*)(ws + OFF_WPROJ), 0, base);
    tconv_job(smem, kp->rwkv_w_o, 512, D, 0, D, (bf16_t*)(ws + OFF_WO), 0, base);
    tconv_job(smem, kp->w_out, D, D, 0, D, (bf16_t*)(ws + OFF_WOUT), 0, base);
    { unsigned* z = (unsigned*)(ws + OFF_WIN1 + (size_t)2432 * D * 2); for (int i = gtid; i < 128 * D / 2; i += gthreads) z[i] = 0u; }
    { bf16_t* wl = (bf16_t*)(ws + OFF_WLORA);
      for (int i = gtid; i < 2560 * 384; i += gthreads) {
          const int n = i / 384, k = i - n * 384, seg = n >> 9, c = n & 511; float v = 0.f;
          if (seg == 0) { if (k < 64) v = kp->rwkv_w2[(size_t)(0 * 64 + k) * 512 + c]; }
          else if (seg == 1) { if (k >= 64 && k < 128) v = kp->rwkv_w2[(size_t)(1 * 64 + k - 64) * 512 + c]; }
          else if (seg == 2) { if (k >= 128 && k < 192) v = kp->rwkv_a2[(size_t)(0 * 64 + k - 128) * 512 + c]; }
          else if (seg == 3) { if (k >= 192 && k < 256) v = kp->rwkv_a2[(size_t)(1 * 64 + k - 192) * 512 + c]; }
          else { if (k >= 256) v = kp->rwkv_g2[(size_t)(k - 256) * 512 + c]; }
          wl[i] = (bf16_t)f2bf(v);
      } }
    { float* abar = (float*)(ws + OFF_S5A); bf16_t* bb = (bf16_t*)(ws + OFF_S5B); bf16_t* cc = (bf16_t*)(ws + OFF_S5C);
      for (int i = gtid; i < 2 * 32 * 64; i += gthreads) {
          const int dg = i >> 6, pp = i & 63;
          const float lre = kp->s5_A_re[i], lim = kp->s5_A_im[i], dt = expf(kp->s5_log_dt[dg]);
          const float mag = expf(dt * lre), abr = mag * cosf(dt * lim), abi = mag * sinf(dt * lim);
          const float den = lre * lre + lim * lim;
          const float zr = ((abr - 1.0f) * lre + abi * lim) / den, zi = (abi * lre - (abr - 1.0f) * lim) / den;
          abar[2 * i] = abr; abar[2 * i + 1] = abi;
          for (int k = 0; k < 16; ++k) {
              const float br = kp->s5_B_re[(size_t)i * 16 + k], bi = kp->s5_B_im[(size_t)i * 16 + k];
              bb[((size_t)dg * 128 + pp) * 16 + k] = (bf16_t)f2bf(zr * br - zi * bi);
              bb[((size_t)dg * 128 + 64 + pp) * 16 + k] = (bf16_t)f2bf(zr * bi + zi * br);
              cc[((size_t)dg * 16 + k) * 128 + 2 * pp] = (bf16_t)f2bf(kp->s5_C_re[((size_t)dg * 16 + k) * 64 + pp]);
              cc[((size_t)dg * 16 + k) * 128 + 2 * pp + 1] = (bf16_t)f2bf(-kp->s5_C_im[((size_t)dg * 16 + k) * 64 + pp]);
          }
      } }
    { float* sc = (float*)smem;
      float* red = sc + 9 * 1024;
      float* MOD = (float*)(ws + OFF_MOD);
      __syncthreads();
      for (int i = tid; i < 9 * 1024; i += NTHR) { const float v = (i < 8 * 1024) ? kp->c[i] : kp->c_ctx[i - 8 * 1024]; sc[i] = siluf_(v); }
      __syncthreads();
      const int kg = tid >> 5, col = tid & 31;
      for (int slab = bid; slab < NMODC / 32; slab += G) {
          const int n0 = slab * 32;
          float a[9];
#pragma unroll
          for (int r = 0; r < 9; ++r) a[r] = 0.f;
          for (int k = kg; k < 1024; k += 16) {
              const float w = kp->w_mod[(size_t)k * NMODC + n0 + col];
#pragma unroll
              for (int r = 0; r < 9; ++r) a[r] += sc[r * 1024 + k] * w;
          }
#pragma unroll
          for (int r = 0; r < 9; ++r) red[(kg * 9 + r) * 32 + col] = a[r];
          __syncthreads();
          if (tid < 288) { const int r = tid >> 5, cl = tid & 31; float s = kp->b_mod[n0 + cl];
#pragma unroll
              for (int q = 0; q < 16; ++q) s += red[(q * 9 + r) * 32 + cl];
              MOD[(size_t)r * NMODC + n0 + cl] = s; }
          __syncthreads();
      } }
}

__device__ __forceinline__ void norm_phase(const float* srcx, const float* srcc, int nrows, const float* g, const float* MOD, int shift_idx, bf16_t* dst) {
    const int tidl = tid_l(); const int wave = tidl >> 6, lane = tidl & 63;
    const int gw = bid_l() * 8 + wave, nw = gridDim.x * 8;
    f32x4 gv[4];
#pragma unroll
    for (int i = 0; i < 4; ++i) gv[i] = *(const f32x4*)(g + lane * 4 + 256 * i);
    f32x4 v[4], s0[4], s1[4], nv[4], n0[4], n1[4];
#define NP_LOAD(V, S0, S1, r) do { const float* src_ = ((r) < TX) ? srcx + (size_t)(r) * D : srcc + (size_t)((r) - TX) * D; \
        const int bi_ = ((r) < TX) ? ((r) >> 12) : 8; const float* sh_ = MOD + (size_t)bi_ * NMODC + shift_idx * 1024; \
        _Pragma("unroll") for (int i = 0; i < 4; ++i) { V[i] = *(const f32x4*)(src_ + lane * 4 + 256 * i); S0[i] = *(const f32x4*)(sh_ + lane * 4 + 256 * i); S1[i] = *(const f32x4*)(sh_ + 1024 + lane * 4 + 256 * i); } } while (0)
    if (gw < nrows) NP_LOAD(v, s0, s1, gw);
    for (int r = gw; r < nrows; r += nw) {
        const int rn = r + nw;
        if (rn < nrows) NP_LOAD(nv, n0, n1, rn);
        float ss = 0.f;
#pragma unroll
        for (int i = 0; i < 4; ++i) ss += v[i][0] * v[i][0] + v[i][1] * v[i][1] + v[i][2] * v[i][2] + v[i][3] * v[i][3];
        ss = wave_sum(ss);
        const float rstd = rsqrtf(ss * (1.0f / 1024.0f) + 1e-6f);
#pragma unroll
        for (int i = 0; i < 4; ++i) {
            const f32x4 o = v[i] * rstd * gv[i] * (s1[i] + 1.0f) + s0[i];
            u32x2 w; w.x = pk2(o[0], o[1]); w.y = pk2(o[2], o[3]);
            *(u32x2*)(dst + (size_t)r * D + lane * 4 + 256 * i) = w;
        }
#pragma unroll
        for (int i = 0; i < 4; ++i) { v[i] = nv[i]; s0[i] = n0[i]; s1[i] = n1[i]; }
    }
#undef NP_LOAD
}
__device__ __forceinline__ void final_norm_phase(float* io, const float* g) {
    const int tidl = tid_l(); const int wave = tidl >> 6, lane = tidl & 63;
    const int gw = bid_l() * 8 + wave, nw = gridDim.x * 8;
    f32x4 gv[4];
#pragma unroll
    for (int i = 0; i < 4; ++i) gv[i] = *(const f32x4*)(g + lane * 4 + 256 * i);
    f32x4 v[4], nv[4];
#pragma unroll
    for (int i = 0; i < 4; ++i) v[i] = *(const f32x4*)(io + (size_t)gw * D + lane * 4 + 256 * i);
    for (int r = gw; r < TX; r += nw) {
        const int rn = r + nw;
        if (rn < TX) {
#pragma unroll
            for (int i = 0; i < 4; ++i) nv[i] = *(const f32x4*)(io + (size_t)rn * D + lane * 4 + 256 * i);
        }
        float ss = 0.f;
#pragma unroll
        for (int i = 0; i < 4; ++i) ss += v[i][0] * v[i][0] + v[i][1] * v[i][1] + v[i][2] * v[i][2] + v[i][3] * v[i][3];
        ss = wave_sum(ss);
        const float rstd = rsqrtf(ss * (1.0f / 1024.0f) + 1e-6f);
#pragma unroll
        for (int i = 0; i < 4; ++i) *(f32x4*)(io + (size_t)r * D + lane * 4 + 256 * i) = v[i] * rstd * gv[i];
#pragma unroll
        for (int i = 0; i < 4; ++i) v[i] = nv[i];
    }
}

__device__ __forceinline__ void conv_phase(KP kp_) {
    KP_LAUNDER(kp, kp_); unsigned char* ws = kp->ws; const float* rwkv_conv = kp->rwkv_conv; const float* rwkv_k_k = kp->rwkv_k_k;
    const bf16_t* RKVP = (const bf16_t*)(ws + A_TAIL); bf16_t* RKV = (bf16_t*)(ws + A_RKV); float* KN = (float*)(ws + OFF_KN);
    const int tidl = tid_l(); const int wave = tidl >> 6, lane = tidl & 63;
    const int gw = bid_l() * 8 + wave, nw = gridDim.x * 8;
    u32x2 tp[9], ntp[9]; f32x4 wt[9], nwt[9]; unsigned vm = 0u, nvm = 0u;
#define CV_LOAD(TP, WT, VM, task_) do { const int t_ = (task_) / 6, grp_ = (task_) - t_ * 6, ch_ = grp_ * 256 + lane * 4; \
        int rowbase_, y_, x_, H_, W_; \
        if (t_ < TX) { const int n_ = t_ & 4095; rowbase_ = t_ - n_; y_ = n_ >> 6; x_ = n_ & 63; H_ = 64; W_ = 64; } \
        else { const int n_ = (t_ - TX) & 255; rowbase_ = t_ - n_; y_ = 0; x_ = n_; H_ = 1; W_ = 256; } \
        VM = 0u; \
        _Pragma("unroll") for (int dy = 0; dy < 3; ++dy) _Pragma("unroll") for (int dx = 0; dx < 3; ++dx) { \
            const int yy_ = y_ + dy - 1, xx_ = x_ + dx - 1; const bool ok_ = (yy_ >= 0) && (yy_ < H_) && (xx_ >= 0) && (xx_ < W_); \
            const int row_ = ok_ ? rowbase_ + yy_ * W_ + xx_ : t_; VM |= ok_ ? (1u << (dy * 3 + dx)) : 0u; \
            TP[dy * 3 + dx] = *(const u32x2*)(RKVP + (size_t)row_ * 1536 + ch_); \
            WT[dy * 3 + dx] = *(const f32x4*)(rwkv_conv + (size_t)(dy * 3 + dx) * 1536 + ch_); } } while (0)
    if (gw < TT * 6) CV_LOAD(tp, wt, vm, gw);
    for (int task = gw; task < TT * 6; task += nw) {
        const int tnx = task + nw;
        if (tnx < TT * 6) CV_LOAD(ntp, nwt, nvm, tnx);
        const int t = task / 6, grp = task - t * 6, ch = grp * 256 + lane * 4;
        float a[4] = {0.f, 0.f, 0.f, 0.f};
#pragma unroll
        for (int q = 0; q < 9; ++q) { const float m = ((vm >> q) & 1u) ? 1.0f : 0.0f; const f32x4 cw = wt[q] * m;
            a[0] += bflo(tp[q].x) * cw[0]; a[1] += bfhi(tp[q].x) * cw[1]; a[2] += bflo(tp[q].y) * cw[2]; a[3] += bfhi(tp[q].y) * cw[3]; }
        u32x2 o; o.x = pk2(a[0], a[1]); o.y = pk2(a[2], a[3]);
        *(u32x2*)(RKV + (size_t)t * 1536 + ch) = o;
        if (grp == 2 || grp == 3) {
            const f32x4 kk = *(const f32x4*)(rwkv_k_k + ch - 512);
            const float k0 = bflo(o.x) * kk[0], k1 = bfhi(o.x) * kk[1], k2 = bflo(o.y) * kk[2], k3 = bfhi(o.y) * kk[3];
            float s = k0 * k0 + k1 * k1 + k2 * k2 + k3 * k3;
            s += __shfl_xor(s, 1); s += __shfl_xor(s, 2); s += __shfl_xor(s, 4); s += __shfl_xor(s, 8);
            if ((lane & 15) == 0) KN[(size_t)t * 8 + ((ch - 512) >> 6)] = rsqrtf(s + 1e-12f);
        }
#pragma unroll
        for (int q = 0; q < 9; ++q) { tp[q] = ntp[q]; wt[q] = nwt[q]; }
        vm = nvm;
    }
#undef CV_LOAD
}

__device__ __forceinline__ int scan_row(int dir, int b, int s) {
    if (s < CTXL) { const int n = dir ? (CTXL - 1 - s) : s; return TX + b * CTXL + n; }
    const int s2 = s - CTXL; const int n = dir ? (SEQ - 1 - s2) : s2; return b * SEQ + n;
}
constexpr int NCHUNK = (CTXL + SEQ) / 16;
constexpr int L_RB = 0;
constexpr int L_VB = 40960;
constexpr int L_YS = 45056;
constexpr int L_S5 = 49152;
constexpr int S5_WB = 14592 + 4096 + 4096;

struct PSet { u32x2 r, k, lw, a; float kn; unsigned v; };

__device__ __forceinline__ void scan_phase(KP kp_, unsigned char* smem) {
    KP_LAUNDER(kp, kp_); unsigned char* ws = kp->ws;
    const int tid = tid_l(), wave = __builtin_amdgcn_readfirstlane(tid >> 6), lane = tid & 63, wg = bid_l();
    bf16_t* YB = (bf16_t*)(ws + A_TAIL + (size_t)2 * TX * 512 * 2);
    float* RB = (float*)(smem + L_RB); float* VB = (float*)(smem + L_VB); float* YS = (float*)(smem + L_YS);
    const int rc = wg >> 1, half = wg & 1, rdir = rc >> 6, rb = (rc >> 3) & 7, rh = rc & 7;
    bf16_t* ybo = YB + (size_t)rdir * TX * 512 + rh * 64 + half * 32 + (tid & 31);
    const int yj = tid >> 5;
#define YSTORE(ci, buf) do { if ((ci) * 16 >= CTXL) { const size_t row = (size_t)scan_row(rdir, rb, (ci) * 16 + yj); ybo[row * 512] = (bf16_t)f2bf(YS[(buf) * 512 + tid]); } } while (0)
    if (wave < 4) {
        __builtin_amdgcn_s_setprio(3);
        f32x2 S2[4];
#pragma unroll
        for (int i = 0; i < 4; ++i) S2[i] = (f32x2){0.f, 0.f};
        const int crow = wave * 8 + (lane >> 3), ccg = lane & 7;
        __syncthreads();
        for (int ci = 0; ci < NCHUNK; ++ci) {
            const int buf = ci & 1;
            const float* rbp = RB + (buf * 16) * 5 * 64 + ccg * 8;
            const float* vbp = VB + buf * 512 + crow;
            f32x4 cw[10], nw[10]; float cv, nv = 0.f;
#pragma unroll
            for (int q = 0; q < 10; ++q) cw[q] = *(const f32x4*)(rbp + (q >> 1) * 64 + (q & 1) * 4);
            cv = vbp[0];
            float yk0 = 0.f, yk1 = 0.f;
#pragma unroll
            for (int j = 0; j < 16; ++j) {
                if (j < 15) {
#pragma unroll
                    for (int q = 0; q < 10; ++q) nw[q] = *(const f32x4*)(rbp + (j + 1) * 320 + (q >> 1) * 64 + (q & 1) * 4);
                    nv = vbp[(j + 1) * 32];
                }
                const f32x2 vi2 = (f32x2){cv, cv};
                f32x2 d0 = S2[0] * (f32x2){cw[4][0], cw[4][1]}; d0 = S2[1] * (f32x2){cw[4][2], cw[4][3]} + d0;
                f32x2 d1 = S2[2] * (f32x2){cw[5][0], cw[5][1]}; d1 = S2[3] * (f32x2){cw[5][2], cw[5][3]} + d1;
                const f32x2 t0 = S2[0] * (f32x2){cw[0][0], cw[0][1]} + vi2 * (f32x2){cw[2][0], cw[2][1]};
                const f32x2 t1 = S2[1] * (f32x2){cw[0][2], cw[0][3]} + vi2 * (f32x2){cw[2][2], cw[2][3]};
                const f32x2 t2 = S2[2] * (f32x2){cw[1][0], cw[1][1]} + vi2 * (f32x2){cw[3][0], cw[3][1]};
                const f32x2 t3 = S2[3] * (f32x2){cw[1][2], cw[1][3]} + vi2 * (f32x2){cw[3][2], cw[3][3]};
                d0 = d0 + d1;
                const float sa = sum8(d0.x + d0.y);
                const f32x2 sa2 = (f32x2){sa, sa};
                S2[0] = sa2 * (f32x2){cw[6][0], cw[6][1]} + t0;
                S2[1] = sa2 * (f32x2){cw[6][2], cw[6][3]} + t1;
                S2[2] = sa2 * (f32x2){cw[7][0], cw[7][1]} + t2;
                S2[3] = sa2 * (f32x2){cw[7][2], cw[7][3]} + t3;
                f32x2 e0 = S2[0] * (f32x2){cw[8][0], cw[8][1]}; e0 = S2[1] * (f32x2){cw[8][2], cw[8][3]} + e0;
                f32x2 e1 = S2[2] * (f32x2){cw[9][0], cw[9][1]}; e1 = S2[3] * (f32x2){cw[9][2], cw[9][3]} + e1;
                e0 = e0 + e1;
                const float y = sum8(e0.x + e0.y);
                if (j < 8) yk0 = (ccg == j) ? y : yk0; else yk1 = (ccg == j - 8) ? y : yk1;
                if (j < 15) {
#pragma unroll
                    for (int q = 0; q < 10; ++q) cw[q] = nw[q];
                    cv = nv;
                }
            }
            YS[buf * 512 + ccg * 32 + crow] = yk0; YS[buf * 512 + (8 + ccg) * 32 + crow] = yk1;
            __syncthreads();
            YSTORE(ci, buf);
        }
        __builtin_amdgcn_s_setprio(0);
    } else if (wave < 6) {
        const bf16_t* U = (const bf16_t*)(ws + A_U);
        bf16_t* YA = (bf16_t*)(ws + A_TAIL);
        const int sc = (wg * 2 + (wave - 4)) & 511, sdir = (sc >> 8) & 1, sb = (sc >> 5) & 7, sg = sc & 31;
        float s_sr = 0.f, s_si = 0.f; u32x4 su[4];
        float* XL = (float*)(smem + L_S5 + (wave - 4) * S5_WB); unsigned* SBU = (unsigned*)((unsigned char*)XL + 10240); const bf16_t* SBF = (const bf16_t*)SBU;
        const bf16_t* s5bb = (const bf16_t*)(ws + OFF_S5B) + (size_t)(sdir * 32 + sg) * 128 * 16;
        const bf16_t* s5cc = (const bf16_t*)(ws + OFF_S5C) + (size_t)(sdir * 32 + sg) * 16 * 128;
        const float* ab = (const float*)(ws + OFF_S5A) + (size_t)((sdir * 32 + sg) * 64 + lane) * 2;
        const float s_are = ab[0], s_aim = ab[1];
        const int n = lane & 15, q = lane >> 4;
        bf16_t* CL = (bf16_t*)((unsigned char*)XL + 14592); bf16_t* BL = CL + 2048;
#pragma unroll
        for (int i = 0; i < 4; ++i) { *(u32x4*)(CL + (lane + 64 * i) * 8) = *(const u32x4*)(s5cc + (lane + 64 * i) * 8);
            *(u32x4*)(BL + (lane + 64 * i) * 8) = *(const u32x4*)(s5bb + (lane + 64 * i) * 8); }
        const u32x4 s5mask = (lane < 32) ? (u32x4){0xffffffffu, 0xffffffffu, 0xffffffffu, 0xffffffffu} : (u32x4){0u, 0u, 0u, 0u};
#define S5_LOAD(Q, ci) do { const int ci_ = (ci) < NCHUNK ? (ci) : NCHUNK - 1; \
        const size_t row = (size_t)scan_row(sdir, sb, ci_ * 16 + n); (Q) = *(const u32x4*)(U + row * 512 + sg * 16 + 8 * (q & 1)); } while (0)
#define CFENCE() asm volatile("" ::: "memory")
        S5_LOAD(su[0], 0); S5_LOAD(su[1], 1); S5_LOAD(su[2], 2); S5_LOAD(su[3], 3);
        __syncthreads();
#define S5_BODY(XPH) \
            _Pragma("unroll") for (int dd = 0; dd < 4; ++dd) { \
                const int ci = cc + dd; const int buf = dd & 1; \
                const bf16x8 au = __builtin_bit_cast(bf16x8, su[dd] & s5mask); \
                _Pragma("unroll") for (int nb = 0; nb < 8; ++nb) { \
                    const bf16x8 bop = *(const bf16x8*)(BL + (16 * nb + n) * 16 + 8 * (q & 1)); \
                    const f32x4 xa = __builtin_amdgcn_mfma_f32_16x16x32_bf16(au, bop, (f32x4){0.f, 0.f, 0.f, 0.f}, 0, 0, 0); \
                    *(f32x4*)(XL + (16 * nb + n) * 20 + 4 * q) = xa; } \
                S5_LOAD(su[dd], ci + 4); \
                CFENCE(); \
                { f32x4 xr[4], xi[4]; \
                  _Pragma("unroll") for (int i = 0; i < 4; ++i) { xr[i] = *(const f32x4*)(XL + lane * 20 + 4 * i); xi[i] = *(const f32x4*)(XL + (64 + lane) * 20 + 4 * i); } \
                  _Pragma("unroll") for (int t = 0; t < 16; ++t) { \
                      const float nr = s_are * s_sr - s_aim * s_si + xr[t >> 2][t & 3]; \
                      const float ni = s_are * s_si + s_aim * s_sr + xi[t >> 2][t & 3]; \
                      s_sr = nr; s_si = ni; \
                      if (XPH) SBU[t * 68 + lane] = pk2(nr, ni); } } \
                CFENCE(); \
                if (XPH) { \
                    f32x4 ya = (f32x4){0.f, 0.f, 0.f, 0.f}; \
                    _Pragma("unroll") for (int ks = 0; ks < 4; ++ks) { \
                        const bf16x8 ay = *(const bf16x8*)(SBF + n * 136 + 32 * ks + 8 * q); \
                        const bf16x8 cop = *(const bf16x8*)(CL + n * 128 + 32 * ks + 8 * q); \
                        ya = __builtin_amdgcn_mfma_f32_16x16x32_bf16(ay, cop, ya, 0, 0, 0); } \
                    bf16_t* yo = YA + (size_t)sdir * TX * 512; \
                    _Pragma("unroll") for (int r = 0; r < 4; ++r) { const size_t row = (size_t)scan_row(sdir, sb, ci * 16 + 4 * q + r); yo[row * 512 + sg * 16 + n] = (bf16_t)f2bf(ya[r]); } } \
                CFENCE(); \
                __syncthreads(); \
                if (XPH) { const size_t row = (size_t)scan_row(rdir, rb, ci * 16 + yj); ybo[row * 512] = (bf16_t)f2bf(YS[buf * 512 + tid]); } \
            }
        for (int cc = 0; cc < CTXL / 16; cc += 4) { S5_BODY(false) }
        for (int cc = CTXL / 16; cc < NCHUNK; cc += 4) { S5_BODY(true) }
#undef S5_BODY
#undef S5_LOAD
#undef CFENCE
    } else {
        const bf16_t* RKV = (const bf16_t*)(ws + A_RKV); const bf16_t* LW = (const bf16_t*)(ws + A_LW); const bf16_t* AI = (const bf16_t*)(ws + A_R0);
        const float* KN = (const float*)(ws + OFF_KN);
        const int ptid = tid - 384, pj = (ptid >> 3) & 15, pc8 = (ptid & 7) * 8;
        float pkk[8], pka[8];
        struct PS8 { u32x4 r, k, lw, a; float kn; u32x2 v; };
        PS8 ps[4];
#pragma unroll
        for (int i = 0; i < 8; ++i) { pkk[i] = kp->rwkv_k_k[rh * 64 + pc8 + i]; pka[i] = kp->rwkv_k_a[rh * 64 + pc8 + i]; }
#define PROD_LOAD(P, ci) do { const int ci_ = (ci) < NCHUNK ? (ci) : NCHUNK - 1; const size_t row = (size_t)scan_row(rdir, rb, ci_ * 16 + pj); \
        (P).r = *(const u32x4*)(RKV + row * 1536 + rh * 64 + pc8); (P).k = *(const u32x4*)(RKV + row * 1536 + 512 + rh * 64 + pc8); \
        (P).lw = *(const u32x4*)(LW + row * 1024 + rdir * 512 + rh * 64 + pc8); (P).a = *(const u32x4*)(AI + row * 1024 + rdir * 512 + rh * 64 + pc8); \
        (P).kn = KN[row * 8 + rh]; (P).v = *(const u32x2*)(RKV + row * 1536 + 1024 + rh * 64 + half * 32 + (ptid & 7) * 4); } while (0)
#define PROD_STORE(P, buf) do { float* d = RB + (((buf) * 16 + pj) * 5) * 64 + pc8; \
        float k_[8], a_[8], l_[8], r_[8], w_[8], kt_[8], aa_[8], bb_[8]; \
        unpack8((P).k, k_); unpack8((P).a, a_); unpack8((P).lw, l_); unpack8((P).r, r_); \
        _Pragma("unroll") for (int i_ = 0; i_ < 8; ++i_) { const float kkv = k_[i_] * pkk[i_] * (P).kn; w_[i_] = __expf(l_[i_]); \
            kt_[i_] = k_[i_] * (1.0f + (a_[i_] - 1.0f) * pka[i_]); aa_[i_] = -kkv; bb_[i_] = kkv * a_[i_]; } \
        *(f32x4*)(d) = (f32x4){w_[0], w_[1], w_[2], w_[3]}; *(f32x4*)(d + 4) = (f32x4){w_[4], w_[5], w_[6], w_[7]}; \
        *(f32x4*)(d + 64) = (f32x4){kt_[0], kt_[1], kt_[2], kt_[3]}; *(f32x4*)(d + 68) = (f32x4){kt_[4], kt_[5], kt_[6], kt_[7]}; \
        *(f32x4*)(d + 128) = (f32x4){aa_[0], aa_[1], aa_[2], aa_[3]}; *(f32x4*)(d + 132) = (f32x4){aa_[4], aa_[5], aa_[6], aa_[7]}; \
        *(f32x4*)(d + 192) = (f32x4){bb_[0], bb_[1], bb_[2], bb_[3]}; *(f32x4*)(d + 196) = (f32x4){bb_[4], bb_[5], bb_[6], bb_[7]}; \
        *(f32x4*)(d + 256) = (f32x4){r_[0], r_[1], r_[2], r_[3]}; *(f32x4*)(d + 260) = (f32x4){r_[4], r_[5], r_[6], r_[7]}; \
        *(f32x4*)(VB + (buf) * 512 + pj * 32 + (ptid & 7) * 4) = (f32x4){bflo((P).v.x), bfhi((P).v.x), bflo((P).v.y), bfhi((P).v.y)}; } while (0)
        PROD_LOAD(ps[0], 0); PROD_STORE(ps[0], 0);
        PROD_LOAD(ps[1], 1); PROD_LOAD(ps[2], 2); PROD_LOAD(ps[3], 3); PROD_LOAD(ps[0], 4);
        __syncthreads();
#define PROD_BODY(XPH) \
            _Pragma("unroll") for (int dd = 0; dd < 4; ++dd) { \
                const int ci = cc + dd; const int buf = dd & 1; \
                __builtin_amdgcn_sched_barrier(0); \
                PROD_STORE(ps[(dd + 1) & 3], buf ^ 1); \
                __builtin_amdgcn_sched_barrier(0); \
                PROD_LOAD(ps[(dd + 1) & 3], ci + 5); \
                __builtin_amdgcn_sched_barrier(0); \
                __syncthreads(); \
                if (XPH) { const size_t row = (size_t)scan_row(rdir, rb, ci * 16 + yj); ybo[row * 512] = (bf16_t)f2bf(YS[buf * 512 + tid]); } \
            }
        for (int cc = 0; cc < CTXL / 16; cc += 4) { PROD_BODY(false) }
        for (int cc = CTXL / 16; cc < NCHUNK; cc += 4) { PROD_BODY(true) }
#undef PROD_BODY
#undef PROD_LOAD
#undef PROD_STORE
    }
#undef YSTORE
}

__device__ __forceinline__ void post_phase(KP kp_) {
    KP_LAUNDER(kp, kp_); unsigned char* ws = kp->ws;
    const int tidl = tid_l(); const int wave = tidl >> 6, lane = tidl & 63;
    const int gw = bid_l() * 8 + wave, nw = gridDim.x * 8;
    const bf16_t* YA = (const bf16_t*)(ws + A_TAIL); const bf16_t* YB = (const bf16_t*)(ws + A_TAIL + (size_t)2 * TX * 512 * 2);
    bf16_t* U = (bf16_t*)(ws + A_U); bf16_t* G = (bf16_t*)(ws + A_G);
    const bf16_t* RKV = (const bf16_t*)(ws + A_RKV); const bf16_t* AI = (const bf16_t*)(ws + A_R0);
    const int c8 = lane * 8;
    float dD[8], ka[8], rk[8], lg[8], lb[8];
#pragma unroll
    for (int j = 0; j < 8; ++j) { dD[j] = kp->s5_D[c8 + j]; ka[j] = kp->rwkv_k_a[c8 + j]; rk[j] = kp->rwkv_r_k[c8 + j]; lg[j] = kp->rwkv_ln_g[c8 + j]; lb[j] = kp->rwkv_ln_b[c8 + j]; }
    u32x4 c[11], nx[11];
#define PP_LOAD(A, t) do { A[0] = *(const u32x4*)(YA + (size_t)(t) * 512 + c8); A[1] = *(const u32x4*)(YA + (size_t)(TX + (t)) * 512 + c8); A[2] = *(const u32x4*)(U + (size_t)(t) * 512 + c8); \
        A[3] = *(const u32x4*)(YB + (size_t)(t) * 512 + c8); A[4] = *(const u32x4*)(YB + (size_t)(TX + (t)) * 512 + c8); \
        A[5] = *(const u32x4*)(RKV + (size_t)(t) * 1536 + c8); A[6] = *(const u32x4*)(RKV + (size_t)(t) * 1536 + 512 + c8); A[7] = *(const u32x4*)(RKV + (size_t)(t) * 1536 + 1024 + c8); \
        A[8] = *(const u32x4*)(AI + (size_t)(t) * 1024 + c8); A[9] = *(const u32x4*)(AI + (size_t)(t) * 1024 + 512 + c8); A[10] = *(const u32x4*)(G + (size_t)(t) * 512 + c8); } while (0)
    PP_LOAD(c, gw);
    for (int t = gw; t < TX; t += nw) {
        const int tn = t + nw;
        if (tn < TX) PP_LOAD(nx, tn);
        {
            float f[8], b[8], u[8], o[8];
            unpack8(c[0], f); unpack8(c[1], b); unpack8(c[2], u);
#pragma unroll
            for (int j = 0; j < 8; ++j) o[j] = geluf_(f[j] + b[j] + dD[j] * u[j]);
            *(u32x4*)(U + (size_t)t * 512 + c8) = pack8(o);
        }
        {
            float f[8], b[8], r[8], k[8], v[8], af[8], ab[8], g[8], o[8];
            unpack8(c[3], f); unpack8(c[4], b); unpack8(c[5], r); unpack8(c[6], k); unpack8(c[7], v); unpack8(c[8], af); unpack8(c[9], ab); unpack8(c[10], g);
            float s = 0.f, bs = 0.f;
#pragma unroll
            for (int j = 0; j < 8; ++j) { f[j] += b[j]; s += f[j];
                const float kt = k[j] * ((1.0f + (af[j] - 1.0f) * ka[j]) + (1.0f + (ab[j] - 1.0f) * ka[j]));
                bs += r[j] * kt * rk[j]; }
            s = sum8(s); bs = sum8(bs);
            const float mu = s * (1.0f / 64.0f);
            float q = 0.f;
#pragma unroll
            for (int j = 0; j < 8; ++j) { const float dlt = f[j] - mu; q += dlt * dlt; }
            q = sum8(q);
            const float rstd = rsqrtf(q * (1.0f / 64.0f) + 64e-5f);
#pragma unroll
            for (int j = 0; j < 8; ++j) o[j] = (((f[j] - mu) * rstd) * lg[j] + lb[j] + bs * v[j]) * g[j];
            *(u32x4*)(G + (size_t)t * 512 + c8) = pack8(o);
        }
#pragma unroll
        for (int i = 0; i < 11; ++i) c[i] = nx[i];
    }
#undef PP_LOAD
}

__global__ void __launch_bounds__(NTHR, 2) fwd_megakernel(Params p_unused) {
    extern __shared__ __attribute__((aligned(16))) unsigned char smem[];
    cg::grid_group grid = cg::this_grid();
    KP kp0 = (KP)__builtin_amdgcn_kernarg_segment_ptr();
#define PH_BEGIN KP_LAUNDER(kp, kp0); unsigned char* ws = kp->ws; const float* MOD = (const float*)(ws + OFF_MOD); float* XC1 = (float*)(ws + OFF_XC1); (void)MOD; (void)XC1;

    volatile LAS unsigned* bst = (volatile LAS unsigned*)((LAS unsigned char*)smem + 131072);
    if (threadIdx.x < 2) bst[threadIdx.x] = 0u;
    { KP_LAUNDER(kpb, kp0); unsigned* bw = (unsigned*)(kpb->ws + OFF_BAR);
      if (blockIdx.x == 0) for (int i = threadIdx.x; i < XCD_BAR_WORDS; i += NTHR) bw[i] = 0u; }
    __syncthreads();
    phase0(kp0, smem);
    grid.sync();
    { KP_LAUNDER(kpb, kp0); (void)xcd_barrier_post((unsigned*)(kpb->ws + OFF_BAR), bst); }
#define GRID_BAR() do { KP_LAUNDER(kpb, kp0); XcdBarrier xb_; xb_.bar = (unsigned*)(kpb->ws + OFF_BAR); xb_.x = xb_xcc_id(); \
        xb_.st = (volatile LAS unsigned*)((LAS unsigned char*)smem + 131072); xcd_barrier(xb_); } while (0)
    { PH_BEGIN norm_phase(kp->x, kp->ctx, TT, kp->norm_g, MOD, 0, (bf16_t*)(ws + A_R0)); }
    GRID_BAR();
    { PH_BEGIN EpiGU e; e.O = (bf16_t*)(ws + A_ACT); run_gemm(smem, (const bf16_t*)(ws + A_R0), (const bf16_t*)(ws + OFF_WGU1), TT, 2 * FF, D, e); }
    GRID_BAR();
    { PH_BEGIN EpiRes e; e.srcx = kp->x; e.dstx = kp->out; e.srcc = kp->ctx; e.dstc = XC1; e.mod = MOD + 2 * 1024; e.scale = 0.5f;
      run_gemm(smem, (const bf16_t*)(ws + A_ACT), (const bf16_t*)(ws + OFF_WD1), TT, D, FF, e); }
    GRID_BAR();
    { PH_BEGIN norm_phase(kp->out, XC1, TT, kp->norm_g + 1024, MOD, 3, (bf16_t*)(ws + A_R0)); }
    GRID_BAR();
    { PH_BEGIN EpiIn e; e.U = (bf16_t*)(ws + A_U); e.RKVP = (bf16_t*)(ws + A_TAIL); e.LA = (bf16_t*)(ws + A_LA);
      run_gemm(smem, (const bf16_t*)(ws + A_R0), (const bf16_t*)(ws + OFF_WIN1), TT, 2560, D, e); }
    GRID_BAR();
    { PH_BEGIN EpiLora e; e.wsb = ws; e.w0 = kp->rwkv_w0; e.a0 = kp->rwkv_a0;
      run_gemm(smem, (const bf16_t*)(ws + A_LA), (const bf16_t*)(ws + OFF_WLORA), TT, 2560, 384, e); }
    conv_phase(kp0);
    GRID_BAR();
    scan_phase(kp0, smem);
    GRID_BAR();
    post_phase(kp0);
    { PH_BEGIN norm_phase(kp->out, XC1, TX, kp->norm_g + 1024, MOD, 3, (bf16_t*)(ws + A_LW)); }
    GRID_BAR();
    { PH_BEGIN EpiBf<0> e; e.O = (bf16_t*)(ws + A_TAIL); e.ld = 2048; e.aux = nullptr; e.ldaux = 0;
      run_gemm(smem, (const bf16_t*)(ws + A_LW), (const bf16_t*)(ws + OFF_WGATE), TX, 2048, D, e); }
    { PH_BEGIN EpiBf<1> e; e.O = (bf16_t*)(ws + A_R0); e.ld = 512; e.aux = (const bf16_t*)(ws + A_U); e.ldaux = 512;
      run_gemm(smem, (const bf16_t*)(ws + A_U), (const bf16_t*)(ws + OFF_WGLU), TX, 512, 512, e); }
    GRID_BAR();
    { PH_BEGIN EpiBf<2> e; e.O = (bf16_t*)(ws + A_RKV); e.ld = 1024; e.aux = (const bf16_t*)(ws + A_TAIL); e.ldaux = 2048;
      run_gemm(smem, (const bf16_t*)(ws + A_R0), (const bf16_t*)(ws + OFF_WPROJ), TX, D, 512, e); }
    { PH_BEGIN EpiBf<3> e; e.O = (bf16_t*)(ws + A_RKV); e.ld = 1024; e.aux = (const bf16_t*)(ws + A_TAIL); e.ldaux = 2048;
      run_gemm(smem, (const bf16_t*)(ws + A_G), (const bf16_t*)(ws + OFF_WO), TX, D, 512, e); }
    GRID_BAR();
    { PH_BEGIN EpiRes e; e.srcx = kp->out; e.dstx = kp->out; e.srcc = XC1; e.dstc = XC1; e.mod = MOD + 5 * 1024; e.scale = 1.0f;
      run_gemm(smem, (const bf16_t*)(ws + A_RKV), (const bf16_t*)(ws + OFF_WOUT), TX, D, D, e); }
    GRID_BAR();
    { PH_BEGIN norm_phase(kp->out, XC1, TX, kp->norm_g + 2048, MOD, 6, (bf16_t*)(ws + A_R0)); }
    GRID_BAR();
    { PH_BEGIN EpiGU e; e.O = (bf16_t*)(ws + A_ACT); run_gemm(smem, (const bf16_t*)(ws + A_R0), (const bf16_t*)(ws + OFF_WGU2), TX, 2 * FF, D, e); }
    GRID_BAR();
    { PH_BEGIN EpiRes e; e.srcx = kp->out; e.dstx = kp->out; e.srcc = XC1; e.dstc = XC1; e.mod = MOD + 8 * 1024; e.scale = 0.5f;
      run_gemm(smem, (const bf16_t*)(ws + A_ACT), (const bf16_t*)(ws + OFF_WD2), TX, D, FF, e); }
    GRID_BAR();
    { PH_BEGIN final_norm_phase(kp->out, kp->final_g); }
}

extern "C" void kernel_launch(void* const* d_in, const int* in_sizes, int n_in, void* d_out, int out_size, void* d_ws, size_t ws_size, hipStream_t stream) {
    static int grid_blocks = 0;
    if (grid_blocks == 0) {
        if (n_in != 35 || out_size != TX * D || ws_size < WS_NEED) { fprintf(stderr, "kernel_launch: unexpected shapes n_in %d out %d ws %zu\n", n_in, out_size, ws_size); grid_blocks = -1; return; }
        int dev = 0, cus = 0, per_cu = 0;
        hipGetDevice(&dev);
        hipDeviceGetAttribute(&cus, hipDeviceAttributeMultiprocessorCount, dev);
        hipFuncSetAttribute((const void*)fwd_megakernel, hipFuncAttributeMaxDynamicSharedMemorySize, LDS_BYTES);
        hipOccupancyMaxActiveBlocksPerMultiprocessor(&per_cu, (const void*)fwd_megakernel, NTHR, LDS_BYTES);
        if (per_cu < 1) { fprintf(stderr, "kernel_launch: occupancy query says %d blocks per CU\n", per_cu); per_cu = 1; }
        (void)hipGetLastError();
        grid_blocks = cus;
        if (grid_blocks != 256) fprintf(stderr, "kernel_launch: %d CUs; the scan phase is laid out for 256 workgroups\n", grid_blocks);
        grid_blocks = 256;
    }
    if (grid_blocks < 0) return;
    Params p{};
    const float** pp = (const float**)&p;
    for (int i = 0; i < 35; ++i) pp[i] = (const float*)d_in[i];
    p.out = (float*)d_out; p.ws = (unsigned char*)d_ws;
    void* args[] = {&p};
    hipError_t e = hipLaunchCooperativeKernel((const void*)fwd_megakernel, dim3(grid_blocks), dim3(NTHR), args, LDS_BYTES, stream);
    if (e != hipSuccess) fprintf(stderr, "cooperative launch failed: %s (grid %d)\n", hipGetErrorString(e), grid_blocks);
}
```

```cpp
#include <hip/hip_runtime.h>
#include <hip/hip_cooperative_groups.h>
#include <cstdio>
#include <cstdint>
namespace cg = cooperative_groups;

namespace pg8 {
#define PG8_LAS __attribute__((address_space(3)))
typedef unsigned short bf16_t;
typedef short bf16x8 __attribute__((ext_vector_type(8)));
typedef float f32x4 __attribute__((ext_vector_type(4)));
typedef unsigned u32x4 __attribute__((ext_vector_type(4)));
typedef unsigned u32x2 __attribute__((ext_vector_type(2)));
constexpr int BM = 256, BK = 64, HALF = 128, HTB = HALF * BK * 2, STAGE_BYTES = 8 * HTB, NXCD = 8, WGM = 8;

__host__ __device__ __forceinline__ int lds_byte(int r, int c) { const int st = (r >> 4) * 2 + (c >> 5), rr = r & 15, cc = c & 31, ob = rr * 64 + cc * 2; return st * 1024 + (ob ^ (((ob >> 9) & 1) << 5)); }
__host__ __device__ __forceinline__ void stage_rc(int b, int& R, int& C) { const int st = b / 1024, sb = b % 1024, swz = sb ^ (((sb >> 9) & 1) << 5); R = (st >> 1) * 16 + swz / 64; C = (st & 1) * 32 + (swz % 64) / 2; }
__host__ __device__ __forceinline__ int perm32(int rho) { const int n = rho >> 4, i = rho & 15; return 8 * (i >> 2) + 4 * n + (i & 3); }

struct Unit { int pm, pn; };
struct Gemm { const bf16_t* A; const bf16_t* Bt; int M, N, K; };

struct StaticOrder {
    int nM, nN, nwg, G, c;
    __host__ __device__ void init(int M, int N, int G_, int c_) { nM = M / BM; nN = N / BM; nwg = nM * nN; G = G_; c = c_; }
    __host__ __device__ bool next(int i, Unit& u) const {
        const long L = (long)i * G + c; if (L >= nwg) return false;
        int wgid = (int)L; { const int q = nwg / NXCD, r = nwg % NXCD, xcd = wgid % NXCD, off = wgid / NXCD; wgid = (xcd < r ? xcd * (q + 1) : r * (q + 1) + (xcd - r) * q) + off; }
        const int nig = WGM * nN, gid = wgid / nig, fm = gid * WGM, gsz = (nM - fm) < WGM ? (nM - fm) : WGM;
        u.pm = fm + ((wgid % nig) % gsz); u.pn = (wgid % nig) / gsz; return true;
    }
    __device__ __forceinline__ void a_ready(const Unit&) const {}
    __device__ __forceinline__ void done(const Unit&) const {}
};

template <class Epi, class Sched>
__device__ __forceinline__ void gemm_phase(PG8_LAS unsigned char* lds, const Gemm g, const Sched& S, const Epi& E) {
    int tid_ = threadIdx.x; asm volatile("" : "+v"(tid_));
    const int tid = tid_, wid = __builtin_amdgcn_readfirstlane(tid >> 6), lane = tid & 63, wr = wid >> 2, wc = wid & 3, fr = lane & 15, fq = lane >> 4;
    const int K = g.K, nt = K / BK;
    unsigned voffA[2], voffB[2];
#pragma unroll
    for (int i = 0; i < 2; ++i) { int R, C; stage_rc(tid * 16 + i * 8192, R, C); const int Rb = Epi::PERM ? ((R & ~31) + perm32(R & 31)) : R;
        voffA[i] = (unsigned)(R * K + C) * 2u; voffB[i] = (unsigned)(Rb * K + C) * 2u; }
    const size_t kstep = (size_t)(BK * 2);
    const size_t hstep = (size_t)HALF * K * 2;
    const size_t tstep = 2 * hstep;
    const unsigned ldsw = (unsigned)wid * 1024u;
    const int aoff = lds_byte(wr * 64 + fr, fq * 8), boff = lds_byte(wc * 32 + fr, fq * 8);
#define PG8_SA(b, h) (((b) * 2 + (h)) * HTB)
#define PG8_SB(b, h) ((4 + (b) * 2 + (h)) * HTB)
#define PG8_STAGE(bufoff, gbase, voff) do { _Pragma("unroll") for (int _i = 0; _i < 2; ++_i) \
        __builtin_amdgcn_global_load_lds((const unsigned*)((const char*)(gbase) + (voff)[_i]), (PG8_LAS unsigned*)(lds + (bufoff) + ldsw + _i * 8192), 16, 0, 0); } while (0)
#define PG8_LDA(dst, b, h) do { _Pragma("unroll") for (int m = 0; m < 4; ++m) _Pragma("unroll") for (int k = 0; k < 2; ++k) dst[m][k] = *(const PG8_LAS bf16x8*)(lds + PG8_SA(b, h) + aoff + m * 2048 + k * 1024); } while (0)
#define PG8_LDB(dst, b, h) do { _Pragma("unroll") for (int n = 0; n < 2; ++n) _Pragma("unroll") for (int k = 0; k < 2; ++k) dst[n][k] = *(const PG8_LAS bf16x8*)(lds + PG8_SB(b, h) + boff + n * 2048 + k * 1024); } while (0)
#define PG8_MMA(ai, bj, At, Bt) do { __builtin_amdgcn_s_setprio(1); _Pragma("unroll") for (int m = 0; m < 4; ++m) _Pragma("unroll") for (int n = 0; n < 2; ++n) _Pragma("unroll") for (int k = 0; k < 2; ++k) \
        acc[ai][bj][m][n] = __builtin_amdgcn_mfma_f32_16x16x32_bf16(Bt[n][k], At[m][k], acc[ai][bj][m][n], 0, 0, 0); __builtin_amdgcn_s_setprio(0); } while (0)
#define PG8_WAIT_V(n) asm volatile("s_waitcnt vmcnt(" #n ")" ::: "memory")
#define PG8_WAIT_L(n) asm volatile("s_waitcnt lgkmcnt(" #n ")" ::: "memory")
#define PG8_BAR __builtin_amdgcn_s_barrier()
#define PG8_SCHED __builtin_amdgcn_sched_barrier(0)
    Unit cur, nxt; int ui = 0;
    if (!S.next(0, cur)) return;
    f32x4 acc[2][2][4][2];
#pragma unroll
    for (int a = 0; a < 2; ++a)
#pragma unroll
        for (int b = 0; b < 2; ++b)
#pragma unroll
            for (int m = 0; m < 4; ++m)
#pragma unroll
                for (int n = 0; n < 2; ++n) acc[a][b][m][n] = (f32x4){0.f, 0.f, 0.f, 0.f};
    bf16x8 At[4][2], B0[2][2], B1[2][2];
    const char* cA = (const char*)g.A + (size_t)cur.pm * tstep; const char* cB = (const char*)g.Bt + (size_t)cur.pn * tstep;
    S.a_ready(cur);
    PG8_STAGE(PG8_SB(0, 0), cB, voffB); PG8_STAGE(PG8_SA(0, 0), cA, voffA); PG8_STAGE(PG8_SB(0, 1), cB + hstep, voffB); PG8_STAGE(PG8_SA(0, 1), cA + hstep, voffA);
    if (wr == 1) PG8_BAR;
    PG8_WAIT_V(4); PG8_BAR;
    PG8_STAGE(PG8_SB(1, 0), cB + kstep, voffB); PG8_STAGE(PG8_SA(1, 0), cA + kstep, voffA); PG8_STAGE(PG8_SB(1, 1), cB + hstep + kstep, voffB);
    PG8_WAIT_V(6); PG8_BAR;
    for (;;) {
        const bool has_next = S.next(ui + 1, nxt);
        const char* nA = has_next ? (const char*)g.A + (size_t)nxt.pm * tstep : cA; const char* nB = has_next ? (const char*)g.Bt + (size_t)nxt.pn * tstep : cB;
        for (int t = 0; t < nt; t += 2) {
            const bool last = (t == nt - 2);
            const char* a1 = cA + (size_t)(t + 1) * kstep;
            const char* a2 = last ? nA : cA + (size_t)(t + 2) * kstep; const char* b2 = last ? nB : cB + (size_t)(t + 2) * kstep;
            const char* a3 = a2 + kstep; const char* b3 = b2 + kstep;
            if (last && has_next) S.a_ready(nxt);
            PG8_LDB(B0, 0, 0); PG8_SCHED; PG8_LDA(At, 0, 0); PG8_STAGE(PG8_SA(1, 1), a1 + hstep, voffA);
            PG8_WAIT_L(8); PG8_BAR; PG8_WAIT_L(0); PG8_MMA(0, 0, At, B0); PG8_BAR; PG8_SCHED;
            PG8_LDB(B1, 0, 1); PG8_STAGE(PG8_SB(0, 0), b2, voffB);
            PG8_BAR; PG8_WAIT_L(0); PG8_MMA(0, 1, At, B1); PG8_BAR;
            PG8_LDA(At, 0, 1); PG8_STAGE(PG8_SA(0, 0), a2, voffA);
            PG8_BAR; PG8_WAIT_L(0); PG8_MMA(1, 0, At, B0); PG8_BAR; PG8_SCHED;
            PG8_STAGE(PG8_SB(0, 1), b2 + hstep, voffB);
            PG8_WAIT_V(6); PG8_BAR; PG8_MMA(1, 1, At, B1); PG8_BAR;
            PG8_LDB(B0, 1, 0); PG8_SCHED; PG8_LDA(At, 1, 0); PG8_STAGE(PG8_SA(0, 1), a2 + hstep, voffA);
            PG8_WAIT_L(8); PG8_BAR; PG8_WAIT_L(0); PG8_MMA(0, 0, At, B0); PG8_BAR; PG8_SCHED;
            PG8_LDB(B1, 1, 1); PG8_STAGE(PG8_SB(1, 0), b3, voffB);
            PG8_BAR; PG8_WAIT_L(0); PG8_MMA(0, 1, At, B1); PG8_BAR;
            PG8_LDA(At, 1, 1); PG8_STAGE(PG8_SA(1, 0), a3, voffA);
            PG8_BAR; PG8_WAIT_L(0); PG8_MMA(1, 0, At, B0); PG8_BAR; PG8_SCHED;
            PG8_STAGE(PG8_SB(1, 1), b3 + hstep, voffB);
            PG8_WAIT_V(6); PG8_BAR; PG8_MMA(1, 1, At, B1); PG8_BAR;
        }
        E(acc, cur, wr, wc, fr, fq); S.done(cur);
        if (!has_next) break;
#pragma unroll
        for (int a = 0; a < 2; ++a)
#pragma unroll
            for (int b = 0; b < 2; ++b)
#pragma unroll
                for (int m = 0; m < 4; ++m)
#pragma unroll
                    for (int n = 0; n < 2; ++n) acc[a][b][m][n] = (f32x4){0.f, 0.f, 0.f, 0.f};
        cur = nxt; cA = nA; cB = nB; ++ui;
    }
    PG8_WAIT_V(0);
    if (wr == 0) PG8_BAR;
    PG8_BAR;
#undef PG8_SA
#undef PG8_SB
#undef PG8_STAGE
#undef PG8_LDA
#undef PG8_LDB
#undef PG8_MMA
#undef PG8_WAIT_V
#undef PG8_WAIT_L
#undef PG8_BAR
#undef PG8_SCHED
}
}

using pg8::bf16_t; using pg8::f32x4; using pg8::u32x4; using pg8::u32x2; using pg8::bf16x8; using pg8::Unit;
typedef float f32x2 __attribute__((ext_vector_type(2)));

constexpr int D = 1024, NB = 8, SEQ = 4096, CTXL = 256, FF = 2816;
constexpr int TX = NB * SEQ, TC = NB * CTXL, TT = TX + TC;
constexpr int NMODC = 9 * D;
constexpr int INC = 4480;
constexpr int NTHR = 512;
constexpr int LDS_BYTES = 131072 + 256;

constexpr size_t OFF_MOD = 4096;
constexpr size_t OFF_S5A = OFF_MOD + (size_t)9 * NMODC * 4;
constexpr size_t OFF_S5B = OFF_S5A + 2 * 32 * 64 * 2 * 4;
constexpr size_t OFF_S5C = OFF_S5B + 2 * 32 * 128 * 16 * 2;
constexpr size_t OFF_KN  = OFF_S5C + 2 * 32 * 16 * 128 * 2;
constexpr size_t OFF_BAR = OFF_KN + (size_t)34816 * 8 * 4;
constexpr size_t OFF_W   = 2097152;
static_assert(OFF_BAR + 3456 * 4 <= OFF_W, "ws");
constexpr size_t SZ_WGU = (size_t)2 * FF * D * 2, SZ_WD = (size_t)D * FF * 2;
constexpr size_t OFF_WGU1 = OFF_W, OFF_WGU2 = OFF_WGU1 + SZ_WGU, OFF_WD1 = OFF_WGU2 + SZ_WGU, OFF_WD2 = OFF_WD1 + SZ_WD;
constexpr size_t OFF_WIN1 = OFF_WD2 + SZ_WD;
constexpr size_t OFF_WGATE = OFF_WIN1 + (size_t)2560 * D * 2;
constexpr size_t OFF_WGLU = OFF_WGATE + (size_t)2048 * D * 2;
constexpr size_t OFF_WPROJ = OFF_WGLU + (size_t)512 * 512 * 2;
constexpr size_t OFF_WO = OFF_WPROJ + (size_t)1024 * 512 * 2;
constexpr size_t OFF_WOUT = OFF_WO + (size_t)1024 * 512 * 2;
constexpr size_t OFF_WLORA = OFF_WOUT + (size_t)1024 * 1024 * 2;
constexpr size_t OFF_XC1 = OFF_WLORA + (size_t)2560 * 384 * 2;
constexpr size_t ARENA = OFF_XC1 + (size_t)TC * D * 4;
constexpr size_t A_R0 = ARENA;
constexpr size_t A_LW = A_R0 + (size_t)TT * D * 2;
constexpr size_t A_U = A_LW + (size_t)TT * D * 2;
constexpr size_t A_RKV = A_U + (size_t)TT * 512 * 2;
constexpr size_t A_G = A_RKV + (size_t)TT * 1536 * 2;
constexpr size_t A_TAIL = A_G + (size_t)TX * 512 * 2;
constexpr size_t A_LA = A_TAIL + (size_t)TT * 1536 * 2;
constexpr size_t A_ACT = A_LW;
constexpr size_t WS_NEED = 536870912;
static_assert(A_TAIL + (size_t)TX * 2048 * 2 <= WS_NEED, "ws");
static_assert(A_LA + (size_t)TT * 384 * 2 <= WS_NEED, "ws");
static_assert(A_ACT + (size_t)TT * FF * 2 <= WS_NEED, "ws");
static_assert(OFF_KN + (size_t)TT * 8 * 4 <= OFF_W, "ws");

struct Params {
    const float *x, *c, *ctx, *c_ctx, *w_mod, *b_mod, *norm_g, *w_gate, *w_up, *w_down, *w_in;
    const float *s5_A_re, *s5_A_im, *s5_log_dt, *s5_B_re, *s5_B_im, *s5_C_re, *s5_C_im, *s5_D, *s5_w_glu, *s5_w_proj;
    const float *rwkv_conv, *rwkv_w0, *rwkv_w2, *rwkv_a0, *rwkv_a2, *rwkv_g2, *rwkv_k_k, *rwkv_k_a, *rwkv_r_k, *rwkv_ln_g, *rwkv_ln_b, *rwkv_w_o, *w_out, *final_g;
    float* out; unsigned char* ws;
};

typedef const __attribute__((address_space(4))) Params* KP;
#define KP_LAUNDER(dst, srcp) KP dst = (srcp); asm volatile("" : "+s"(dst))

__device__ __forceinline__ int tid_l() { int t = threadIdx.x; asm volatile("" : "+v"(t)); return t; }
__device__ __forceinline__ int bid_l() { int t = blockIdx.x; asm volatile("" : "+s"(t)); return t; }
__device__ __forceinline__ float bf2f(unsigned v) { return __uint_as_float(v << 16); }
__device__ __forceinline__ unsigned f2bf(float f) { unsigned u = __float_as_uint(f); return (u + 0x7fffu + ((u >> 16) & 1u)) >> 16; }
typedef __bf16 bf16x2_hw __attribute__((ext_vector_type(2)));
__device__ __forceinline__ unsigned pk2(float lo, float hi) { const f32x2 v = (f32x2){lo, hi}; return __builtin_bit_cast(unsigned, __builtin_convertvector(v, bf16x2_hw)); }
__device__ __forceinline__ float bflo(unsigned w) { return __uint_as_float(w << 16); }
__device__ __forceinline__ float bfhi(unsigned w) { return __uint_as_float(w & 0xffff0000u); }
__device__ __forceinline__ float sigmoidf_(float x) { return __builtin_amdgcn_rcpf(1.0f + __expf(-x)); }
__device__ __forceinline__ float tanhf_(float x) { const float e = __expf(2.0f * x); return 1.0f - 2.0f * __builtin_amdgcn_rcpf(e + 1.0f); }
__device__ __forceinline__ float siluf_(float x) { return x * __builtin_amdgcn_rcpf(1.0f + __expf(-x)); }
__device__ __forceinline__ float geluf_(float x) { const float u = 0.7978845608f * (x + 0.044715f * x * x * x); return 0.5f * x * (1.0f + tanhf_(u)); }
__device__ __forceinline__ void unpack8(const u32x4 w, float* f) { f[0] = bflo(w.x); f[1] = bfhi(w.x); f[2] = bflo(w.y); f[3] = bfhi(w.y); f[4] = bflo(w.z); f[5] = bfhi(w.z); f[6] = bflo(w.w); f[7] = bfhi(w.w); }
__device__ __forceinline__ u32x4 pack8(const float* f) { u32x4 w; w.x = pk2(f[0], f[1]); w.y = pk2(f[2], f[3]); w.z = pk2(f[4], f[5]); w.w = pk2(f[6], f[7]); return w; }
__device__ __forceinline__ float wave_sum(float v) {
#pragma unroll
    for (int o = 32; o >= 1; o >>= 1) v += __shfl_xor(v, o);
    return v;
}
template <int CTRL> __device__ __forceinline__ float dpp_f(float v) { return __int_as_float(__builtin_amdgcn_update_dpp(0, __float_as_int(v), CTRL, 0xF, 0xF, true)); }
__device__ __forceinline__ float sum16(float v) {
    v += dpp_f<0xB1>(v);
    v += dpp_f<0x4E>(v);
    v += dpp_f<0x141>(v);
    v += dpp_f<0x140>(v);
    return v;
}
__device__ __forceinline__ float sum8(float v) {
    v += dpp_f<0xB1>(v);
    v += dpp_f<0x4E>(v);
    v += dpp_f<0x141>(v);
    return v;
}


#define LAS __attribute__((address_space(3)))
#define XB_TMO      128
#define XB_XCNT(j)  (256  + 64 * (j))
#define XB_XSUB(j)  (1280 + 64 * (j))
#define XB_XGEN(j)  (2304 + 64 * (j))
#define XB_TOP      3328
#define XB_TOPGEN   3392
#define XCD_BAR_WORDS 3456
#define XB_SPIN_CAP (1u << 18)
__device__ __forceinline__ unsigned xb_ld(unsigned* p)              { return __hip_atomic_load(p, __ATOMIC_RELAXED, __HIP_MEMORY_SCOPE_AGENT); }
__device__ __forceinline__ unsigned xb_add(unsigned* p, unsigned v) { return __hip_atomic_fetch_add(p, v, __ATOMIC_RELAXED, __HIP_MEMORY_SCOPE_AGENT); }
__device__ __forceinline__ unsigned xb_xcc_id() { return (unsigned)__builtin_amdgcn_s_getreg((3 << 11) | 20) & 0xFu; }
#define XB_SPIN(cond, bar) do { unsigned _sp = 0; while (cond) { __builtin_amdgcn_s_sleep(1); \
    if ((++_sp & 255u) == 0u) { if (xb_ld(&(bar)[XB_TMO])) break; if (_sp > XB_SPIN_CAP) { atomicAdd(&(bar)[XB_TMO], 1u); break; } } } } while (0)
struct XcdBarrier { unsigned* bar; unsigned x; volatile LAS unsigned* st; };
__device__ __forceinline__ XcdBarrier xcd_barrier_post(unsigned* bar, volatile LAS unsigned* st) {
    XcdBarrier b; b.bar = bar; b.x = xb_xcc_id(); b.st = st;
    if (threadIdx.x == 0) (void)xb_add(&bar[XB_XCNT(b.x)], 1u);
    return b;
}
__device__ __forceinline__ void xcd_barrier_complete(unsigned* bar, unsigned x, unsigned& nloc, unsigned& nx) {
    const unsigned G = gridDim.x * gridDim.y * gridDim.z;
    unsigned sum, cnt, mine, sp = 0u;
    for (;;) {
        sum = 0u; cnt = 0u; mine = 0u;
#pragma unroll
        for (unsigned j = 0; j < 16; ++j) { const unsigned c = xb_ld(&bar[XB_XCNT(j)]); sum += c; cnt += (c > 0u) ? 1u : 0u; mine = (j == x) ? c : mine; }
        if (sum == G) break;
        __builtin_amdgcn_s_sleep(1);
        if ((++sp & 255u) == 0u) { if (xb_ld(&bar[XB_TMO])) break; if (sp > XB_SPIN_CAP) { atomicAdd(&bar[XB_TMO], 1u); break; } }
    }
    nloc = mine > 0u ? mine : 1u; nx = cnt > 0u ? cnt : 1u;
}
__device__ __forceinline__ void xcd_barrier(const XcdBarrier& b) {
    asm volatile("s_waitcnt vmcnt(0)" ::: "memory");
    __syncthreads();
    if (threadIdx.x == 0) {
        unsigned* bar = b.bar;
        __builtin_amdgcn_s_waitcnt(0);
        unsigned nloc = b.st[0], nx = b.st[1];
        if (nloc == 0u) { xcd_barrier_complete(bar, b.x, nloc, nx); b.st[0] = nloc; b.st[1] = nx; }
        const unsigned old = xb_add(&bar[XB_XSUB(b.x)], 1u);
        const unsigned gen = old / nloc;
        if (old + 1u == (gen + 1u) * nloc) {
            __builtin_amdgcn_fence(__ATOMIC_RELEASE, "agent");
            asm volatile("s_waitcnt vmcnt(0)" ::: "memory");
            const unsigned og = xb_add(&bar[XB_TOP], 1u);
            const unsigned tg = og / nx;
            if (og + 1u == (tg + 1u) * nx) xb_add(&bar[XB_TOPGEN], 1u);
            else XB_SPIN(xb_ld(&bar[XB_TOPGEN]) == tg, bar);
            __builtin_amdgcn_fence(__ATOMIC_ACQUIRE, "agent");
            xb_add(&bar[XB_XGEN(b.x)], 1u);
            asm volatile("s_waitcnt vmcnt(0)" ::: "memory");
        } else {
            XB_SPIN(xb_ld(&bar[XB_XGEN(b.x)]) == gen, bar);
            __builtin_amdgcn_fence(__ATOMIC_ACQUIRE, "agent");
            asm volatile("s_waitcnt vmcnt(0)" ::: "memory");
        }
    }
    __syncthreads();
}

struct EpiGU {
    static constexpr bool PERM = true;
    bf16_t* O;
    __device__ __forceinline__ void operator()(f32x4 (&acc)[2][2][4][2], const Unit& u, int wr, int wc, int fr, int fq) const {
        asm volatile("" : "+v"(fr), "+v"(fq));
        const int row0 = u.pm * 256 + wr * 64 + fr, col0 = (u.pn * 256 + wc * 32 + 8 * fq) >> 1;
#pragma unroll
        for (int ai = 0; ai < 2; ++ai)
#pragma unroll
            for (int m = 0; m < 4; ++m) { bf16_t* rowp = O + (size_t)(row0 + ai * 128 + m * 16) * FF + col0;
#pragma unroll
                for (int bj = 0; bj < 2; ++bj) { const f32x4 g = acc[ai][bj][m][0], up = acc[ai][bj][m][1];
                    u32x2 w; w.x = pk2(siluf_(g[0]) * up[0], siluf_(g[1]) * up[1]); w.y = pk2(siluf_(g[2]) * up[2], siluf_(g[3]) * up[3]);
                    *(u32x2*)(rowp + bj * 64) = w; } }
    }
};
struct EpiRes {
    static constexpr bool PERM = false;
    const float* srcx; float* dstx; const float* srcc; float* dstc; const float* mod; float scale; int rowoff;
    __device__ __forceinline__ void operator()(f32x4 (&acc)[2][2][4][2], const Unit& u, int wr, int wc, int fr, int fq) const {
        asm volatile("" : "+v"(fr), "+v"(fq));
        const int rowt = u.pm * 256 + rowoff; const bool isx = rowt < TX;
        const int bi = isx ? (rowt >> 12) : 8;
        const float* src = isx ? srcx : srcc - (size_t)TX * D; float* dst = isx ? dstx : dstc - (size_t)TX * D;
        const int row0 = rowt + wr * 64 + fr, col0 = u.pn * 256 + wc * 32 + 4 * fq;
#pragma unroll
        for (int bj = 0; bj < 2; ++bj)
#pragma unroll
            for (int n = 0; n < 2; ++n) { const f32x4 mv = *(const f32x4*)(mod + (size_t)bi * NMODC + col0 + bj * 128 + n * 16) * scale;
#pragma unroll
                for (int ai = 0; ai < 2; ++ai)
#pragma unroll
                    for (int m = 0; m < 4; ++m) acc[ai][bj][m][n] *= mv; }
        f32x4 cur[4], nxt[4];
#pragma unroll
        for (int q = 0; q < 4; ++q) cur[q] = *(const f32x4*)(src + (size_t)row0 * D + col0 + (q >> 1) * 128 + (q & 1) * 16);
#pragma unroll
        for (int g = 0; g < 8; ++g) {
            const int ai = g >> 2, m = g & 3;
            if (g < 7) { const size_t rn = (size_t)(row0 + ((g + 1) >> 2) * 128 + ((g + 1) & 3) * 16) * D + col0;
#pragma unroll
                for (int q = 0; q < 4; ++q) nxt[q] = *(const f32x4*)(src + rn + (q >> 1) * 128 + (q & 1) * 16); }
            const size_t ro = (size_t)(row0 + ai * 128 + m * 16) * D + col0;
#pragma unroll
            for (int q = 0; q < 4; ++q) *(f32x4*)(dst + ro + (q >> 1) * 128 + (q & 1) * 16) = cur[q] + acc[ai][q >> 1][m][q & 1];
#pragma unroll
            for (int q = 0; q < 4; ++q) cur[q] = nxt[q];
        }
    }
};
struct EpiIn {
    static constexpr bool PERM = true;
    bf16_t *U, *RKVP, *LA;
    __device__ __forceinline__ void operator()(f32x4 (&acc)[2][2][4][2], const Unit& u, int wr, int wc, int fr, int fq) const {
        asm volatile("" : "+v"(fr), "+v"(fq));
        const int row0 = u.pm * 256 + wr * 64 + fr;
#pragma unroll
        for (int bj = 0; bj < 2; ++bj) {
            const int c0 = u.pn * 256 + bj * 128 + wc * 32 + 8 * fq;
            if (c0 >= 2432) continue;
            bf16_t* base; int ld, cc, act = 0;
            if (c0 < 512) { base = U; ld = 512; cc = c0; }
            else if (c0 < 2048) { base = RKVP; ld = 1536; cc = c0 - 512; }
            else { base = LA; ld = 384; cc = c0 - 2048; act = (cc < 128) ? 1 : (cc < 256 ? 0 : 2); }
#pragma unroll
            for (int ai = 0; ai < 2; ++ai)
#pragma unroll
                for (int m = 0; m < 4; ++m) {
                    float v[8];
#pragma unroll
                    for (int j = 0; j < 4; ++j) { v[j] = acc[ai][bj][m][0][j]; v[4 + j] = acc[ai][bj][m][1][j]; }
                    if (act == 1) {
#pragma unroll
                        for (int j = 0; j < 8; ++j) v[j] = tanhf_(v[j]);
                    } else if (act == 2) {
#pragma unroll
                        for (int j = 0; j < 8; ++j) v[j] = sigmoidf_(v[j]);
                    }
                    *(u32x4*)(base + (size_t)(row0 + ai * 128 + m * 16) * ld + cc) = pack8(v);
                }
        }
    }
};
struct EpiLora {
    static constexpr bool PERM = true;
    unsigned char* wsb; const float *w0, *a0;
    __device__ __forceinline__ void operator()(f32x4 (&acc)[2][2][4][2], const Unit& u, int wr, int wc, int fr, int fq) const {
        asm volatile("" : "+v"(fr), "+v"(fq));
        const int seg = u.pn >> 2;
        if (seg == 2 && u.pm * 256 >= TX) return;
        const size_t boff = (size_t)(seg == 0) * A_LW + (size_t)(seg == 1) * A_R0 + (size_t)(seg == 2) * A_G;
        bf16_t* base = (bf16_t*)(wsb + boff);
        const int ld = seg == 2 ? 512 : 1024;
        const float* bp = w0 + (seg == 1 ? (a0 - w0) : (ptrdiff_t)0);
        const float mul = seg == 0 ? -0.6065306597f : 1.0f;
        const int row0 = u.pm * 256 + wr * 64 + fr;
#pragma unroll
        for (int bj = 0; bj < 2; ++bj) {
            const int cc = (u.pn & 3) * 256 + bj * 128 + wc * 32 + 8 * fq;
            float bias[8];
#pragma unroll
            for (int j = 0; j < 8; ++j) bias[j] = (seg == 2) ? 0.f : bp[cc + j];
#pragma unroll
            for (int ai = 0; ai < 2; ++ai)
#pragma unroll
                for (int m = 0; m < 4; ++m) {
                    float v[8];
#pragma unroll
                    for (int j = 0; j < 4; ++j) { v[j] = acc[ai][bj][m][0][j]; v[4 + j] = acc[ai][bj][m][1][j]; }
                    if (seg != 2) {
#pragma unroll
                        for (int j = 0; j < 8; ++j) v[j] = mul * sigmoidf_(v[j] + bias[j]);
                    }
                    *(u32x4*)(base + (size_t)(row0 + ai * 128 + m * 16) * ld + cc) = pack8(v);
                }
        }
    }
};
template <int MODE> struct EpiBf {
    static constexpr bool PERM = true;
    bf16_t* O; int ld; const bf16_t* aux; int ldaux;
    __device__ __forceinline__ void operator()(f32x4 (&acc)[2][2][4][2], const Unit& u, int wr, int wc, int fr, int fq) const {
        asm volatile("" : "+v"(fr), "+v"(fq));
        const int row0 = u.pm * 256 + wr * 64 + fr, col0 = u.pn * 256 + wc * 32 + 8 * fq;
        const int auxc = (MODE == 3) ? 1024 + col0 : col0;
        u32x4 ca[2], co[2], na[2], no[2];
        if (MODE >= 1) {
#pragma unroll
            for (int bj = 0; bj < 2; ++bj) { ca[bj] = *(const u32x4*)(aux + (size_t)row0 * ldaux + auxc + bj * 128);
                if (MODE == 3) co[bj] = *(const u32x4*)(O + (size_t)row0 * ld + col0 + bj * 128); }
        }
#pragma unroll
        for (int g = 0; g < 8; ++g) {
            const int ai = g >> 2, m = g & 3;
            const size_t row = (size_t)(row0 + ai * 128 + m * 16);
            if (MODE >= 1 && g < 7) { const size_t rn = (size_t)(row0 + ((g + 1) >> 2) * 128 + ((g + 1) & 3) * 16);
#pragma unroll
                for (int bj = 0; bj < 2; ++bj) { na[bj] = *(const u32x4*)(aux + rn * ldaux + auxc + bj * 128);
                    if (MODE == 3) no[bj] = *(const u32x4*)(O + rn * ld + col0 + bj * 128); } }
#pragma unroll
            for (int bj = 0; bj < 2; ++bj) {
                float v[8];
#pragma unroll
                for (int j = 0; j < 4; ++j) { v[j] = acc[ai][bj][m][0][j]; v[4 + j] = acc[ai][bj][m][1][j]; }
                if (MODE == 0) {
#pragma unroll
                    for (int j = 0; j < 8; ++j) v[j] = sigmoidf_(v[j]);
                } else if (MODE == 1) {
                    float a[8]; unpack8(ca[bj], a);
#pragma unroll
                    for (int j = 0; j < 8; ++j) v[j] = a[j] * sigmoidf_(v[j]);
                } else if (MODE == 2) {
                    float a[8]; unpack8(ca[bj], a);
#pragma unroll
                    for (int j = 0; j < 8; ++j) v[j] = a[j] * v[j];
                } else {
                    float a[8], o[8]; unpack8(ca[bj], a); unpack8(co[bj], o);
#pragma unroll
                    for (int j = 0; j < 8; ++j) v[j] = o[j] + a[j] * v[j];
                }
                *(u32x4*)(O + row * ld + col0 + bj * 128) = pack8(v);
            }
            if (MODE >= 1) {
#pragma unroll
                for (int bj = 0; bj < 2; ++bj) { ca[bj] = na[bj]; if (MODE == 3) co[bj] = no[bj]; }
            }
        }
    }
};

template <class Epi>
__device__ __forceinline__ void run_gemm(unsigned char* smem, const bf16_t* A, const bf16_t* Bt, int M, int N, int K, const Epi& E, int G = 0, int c = -1) {
    pg8::Gemm g; g.A = A; g.Bt = Bt; g.M = M; g.N = N; g.K = K;
    pg8::StaticOrder S; S.init(M, N, G > 0 ? G : (int)gridDim.x, c >= 0 ? c : bid_l());
    pg8::gemm_phase<Epi, pg8::StaticOrder>((PG8_LAS unsigned char*)smem, g, S, E);
}

__device__ __forceinline__ void tconv_job(unsigned char* smem, const float* src, int K, int ldsrc, int c0, int ncols, bf16_t* dst, int mode, int& base) {
    float* tile = (float*)smem;
    const int G = gridDim.x, bid = bid_l(), tid = tid_l();
    const int ntn = ncols / 64, ntk = K / 64, ntiles = ntn * ntk;
    int t = (bid - (base % G) + G) % G;
    for (; t < ntiles; t += G) {
        const int tk = t / ntn, tn = t % ntn, k0 = tk * 64, n0 = tn * 64;
        {
            const int r = tid >> 4, c4 = tid & 15;
#pragma unroll
            for (int i = 0; i < 2; ++i) {
                const f32x4 v = *(const f32x4*)(src + (size_t)(k0 + r + 32 * i) * ldsrc + c0 + n0 + 4 * c4);
                float* tp = tile + (r + 32 * i) * 65 + 4 * c4; tp[0] = v[0]; tp[1] = v[1]; tp[2] = v[2]; tp[3] = v[3];
            }
        }
        __syncthreads();
        {
            const int n = tid >> 3, k8 = tid & 7;
            float v[8];
#pragma unroll
            for (int j = 0; j < 8; ++j) v[j] = tile[(8 * k8 + j) * 65 + n];
            const int ng = n0 + n;
            const int row = (mode == 0) ? ng : ((ng >> 2) * 8 + (ng & 3) + (mode == 2 ? 4 : 0));
            *(u32x4*)(dst + (size_t)row * K + k0 + 8 * k8) = pack8(v);
        }
        __syncthreads();
    }
    base += ntiles;
}

__device__ __forceinline__ void phase0(KP kp_, unsigned char* smem) {
    KP_LAUNDER(kp, kp_);
    unsigned char* ws = kp->ws;
    const int G = gridDim.x, bid = bid_l(), tid = tid_l();
    const int gtid = bid * NTHR + tid, gthreads = G * NTHR;
    int base = 0;
    for (int l = 0; l < 2; ++l) {
        bf16_t* wgu = (bf16_t*)(ws + (l == 0 ? OFF_WGU1 : OFF_WGU2));
        tconv_job(smem, kp->w_gate + (size_t)l * D * FF, D, FF, 0, FF, wgu, 1, base);
        tconv_job(smem, kp->w_up + (size_t)l * D * FF, D, FF, 0, FF, wgu, 2, base);
        tconv_job(smem, kp->w_down + (size_t)l * FF * D, FF, D, 0, D, (bf16_t*)(ws + (l == 0 ? OFF_WD1 : OFF_WD2)), 0, base);
    }
    tconv_job(smem, kp->w_in, D, INC, 0, 2432, (bf16_t*)(ws + OFF_WIN1), 0, base);
    tconv_job(smem, kp->w_in, D, INC, 2432, 2048, (bf16_t*)(ws + OFF_WGATE), 0, base);
    tconv_job(smem, kp->s5_w_glu, 512, 512, 0, 512, (bf16_t*)(ws + OFF_WGLU), 0, base);
    tconv_job(smem, kp->s5_w_proj, 512, D, 0, D, (bf16_t*)(ws + OFF_WPROJ), 0, base);
    tconv_job(smem, kp->rwkv_w_o, 512, D, 0, D, (bf16_t*)(ws + OFF_WO), 0, base);
    tconv_job(smem, kp->w_out, D, D, 0, D, (bf16_t*)(ws + OFF_WOUT), 0, base);
    { unsigned* z = (unsigned*)(ws + OFF_WIN1 + (size_t)2432 * D * 2); for (int i = gtid; i < 128 * D / 2; i += gthreads) z[i] = 0u; }
    { bf16_t* wl = (bf16_t*)(ws + OFF_WLORA);
      for (int i = gtid; i < 2560 * 384; i += gthreads) {
          const int n = i / 384, k = i - n * 384, seg = n >> 9, c = n & 511; float v = 0.f;
          if (seg == 0) { if (k < 64) v = kp->rwkv_w2[(size_t)(0 * 64 + k) * 512 + c]; }
          else if (seg == 1) { if (k >= 64 && k < 128) v = kp->rwkv_w2[(size_t)(1 * 64 + k - 64) * 512 + c]; }
          else if (seg == 2) { if (k >= 128 && k < 192) v = kp->rwkv_a2[(size_t)(0 * 64 + k - 128) * 512 + c]; }
          else if (seg == 3) { if (k >= 192 && k < 256) v = kp->rwkv_a2[(size_t)(1 * 64 + k - 192) * 512 + c]; }
          else { if (k >= 256) v = kp->rwkv_g2[(size_t)(k - 256) * 512 + c]; }
          wl[i] = (bf16_t)f2bf(v);
      } }
    { float* abar = (float*)(ws + OFF_S5A); bf16_t* bb = (bf16_t*)(ws + OFF_S5B); bf16_t* cc = (bf16_t*)(ws + OFF_S5C);
      for (int i = gtid; i < 2 * 32 * 64; i += gthreads) {
          const int dg = i >> 6, pp = i & 63;
          const float lre = kp->s5_A_re[i], lim = kp->s5_A_im[i], dt = expf(kp->s5_log_dt[dg]);
          const float mag = expf(dt * lre), abr = mag * cosf(dt * lim), abi = mag * sinf(dt * lim);
          const float den = lre * lre + lim * lim;
          const float zr = ((abr - 1.0f) * lre + abi * lim) / den, zi = (abi * lre - (abr - 1.0f) * lim) / den;
          abar[2 * i] = abr; abar[2 * i + 1] = abi;
          for (int k = 0; k < 16; ++k) {
              const float br = kp->s5_B_re[(size_t)i * 16 + k], bi = kp->s5_B_im[(size_t)i * 16 + k];
              bb[((size_t)dg * 128 + pp) * 16 + k] = (bf16_t)f2bf(zr * br - zi * bi);
              bb[((size_t)dg * 128 + 64 + pp) * 16 + k] = (bf16_t)f2bf(zr * bi + zi * br);
              cc[((size_t)dg * 16 + k) * 128 + 2 * pp] = (bf16_t)f2bf(kp->s5_C_re[((size_t)dg * 16 + k) * 64 + pp]);
              cc[((size_t)dg * 16 + k) * 128 + 2 * pp + 1] = (bf16_t)f2bf(-kp->s5_C_im[((size_t)dg * 16 + k) * 64 + pp]);
          }
      } }
    { float* sc = (float*)smem;
      float* red = sc + 9 * 1024;
      float* MOD = (float*)(ws + OFF_MOD);
      __syncthreads();
      for (int i = tid; i < 9 * 1024; i += NTHR) { const float v = (i < 8 * 1024) ? kp->c[i] : kp->c_ctx[i - 8 * 1024]; sc[i] = siluf_(v); }
      __syncthreads();
      const int kg = tid >> 5, col = tid & 31;
      for (int slab = bid; slab < NMODC / 32; slab += G) {
          const int n0 = slab * 32;
          float a[9];
#pragma unroll
          for (int r = 0; r < 9; ++r) a[r] = 0.f;
          for (int k = kg; k < 1024; k += 16) {
              const float w = kp->w_mod[(size_t)k * NMODC + n0 + col];
#pragma unroll
              for (int r = 0; r < 9; ++r) a[r] += sc[r * 1024 + k] * w;
          }
#pragma unroll
          for (int r = 0; r < 9; ++r) red[(kg * 9 + r) * 32 + col] = a[r];
          __syncthreads();
          if (tid < 288) { const int r = tid >> 5, cl = tid & 31; float s = kp->b_mod[n0 + cl];
#pragma unroll
              for (int q = 0; q < 16; ++q) s += red[(q * 9 + r) * 32 + cl];
              MOD[(size_t)r * NMODC + n0 + cl] = s; }
          __syncthreads();
      } }
}

__device__ __forceinline__ void norm_phase(const float* srcx, const float* srcc, int nrows, const float* g, const float* MOD, int shift_idx, bf16_t* dst, int rbeg = 0, int wgi = -1, int wgn = 0) {
    const int tidl = tid_l(); const int wave = tidl >> 6, lane = tidl & 63;
    const int gw = rbeg + (wgi >= 0 ? wgi : bid_l()) * 8 + wave, nw = (wgn > 0 ? wgn : (int)gridDim.x) * 8;
    f32x4 gv[4];
#pragma unroll
    for (int i = 0; i < 4; ++i) gv[i] = *(const f32x4*)(g + lane * 4 + 256 * i);
    f32x4 v[4], s0[4], s1[4], nv[4], n0[4], n1[4];
#define NP_LOAD(V, S0, S1, r) do { const float* src_ = ((r) < TX) ? srcx + (size_t)(r) * D : srcc + (size_t)((r) - TX) * D; \
        const int bi_ = ((r) < TX) ? ((r) >> 12) : 8; const float* sh_ = MOD + (size_t)bi_ * NMODC + shift_idx * 1024; \
        _Pragma("unroll") for (int i = 0; i < 4; ++i) { V[i] = *(const f32x4*)(src_ + lane * 4 + 256 * i); S0[i] = *(const f32x4*)(sh_ + lane * 4 + 256 * i); S1[i] = *(const f32x4*)(sh_ + 1024 + lane * 4 + 256 * i); } } while (0)
    if (gw < nrows) NP_LOAD(v, s0, s1, gw);
    for (int r = gw; r < nrows; r += nw) {
        const int rn = r + nw;
        if (rn < nrows) NP_LOAD(nv, n0, n1, rn);
        float ss = 0.f;
#pragma unroll
        for (int i = 0; i < 4; ++i) ss += v[i][0] * v[i][0] + v[i][1] * v[i][1] + v[i][2] * v[i][2] + v[i][3] * v[i][3];
        ss = wave_sum(ss);
        const float rstd = rsqrtf(ss * (1.0f / 1024.0f) + 1e-6f);
#pragma unroll
        for (int i = 0; i < 4; ++i) {
            const f32x4 o = v[i] * rstd * gv[i] * (s1[i] + 1.0f) + s0[i];
            u32x2 w; w.x = pk2(o[0], o[1]); w.y = pk2(o[2], o[3]);
            *(u32x2*)(dst + (size_t)r * D + lane * 4 + 256 * i) = w;
        }
#pragma unroll
        for (int i = 0; i < 4; ++i) { v[i] = nv[i]; s0[i] = n0[i]; s1[i] = n1[i]; }
    }
#undef NP_LOAD
}
__device__ __forceinline__ void final_norm_phase(float* io, const float* g) {
    const int tidl = tid_l(); const int wave = tidl >> 6, lane = tidl & 63;
    const int gw = bid_l() * 8 + wave, nw = gridDim.x * 8;
    f32x4 gv[4];
#pragma unroll
    for (int i = 0; i < 4; ++i) gv[i] = *(const f32x4*)(g + lane * 4 + 256 * i);
    f32x4 v[4], nv[4];
#pragma unroll
    for (int i = 0; i < 4; ++i) v[i] = *(const f32x4*)(io + (size_t)gw * D + lane * 4 + 256 * i);
    for (int r = gw; r < TX; r += nw) {
        const int rn = r + nw;
        if (rn < TX) {
#pragma unroll
            for (int i = 0; i < 4; ++i) nv[i] = *(const f32x4*)(io + (size_t)rn * D + lane * 4 + 256 * i);
        }
        float ss = 0.f;
#pragma unroll
        for (int i = 0; i < 4; ++i) ss += v[i][0] * v[i][0] + v[i][1] * v[i][1] + v[i][2] * v[i][2] + v[i][3] * v[i][3];
        ss = wave_sum(ss);
        const float rstd = rsqrtf(ss * (1.0f / 1024.0f) + 1e-6f);
#pragma unroll
        for (int i = 0; i < 4; ++i) *(f32x4*)(io + (size_t)r * D + lane * 4 + 256 * i) = v[i] * rstd * gv[i];
#pragma unroll
        for (int i = 0; i < 4; ++i) v[i] = nv[i];
    }
}

__device__ __forceinline__ void conv_phase(KP kp_) {
    KP_LAUNDER(kp, kp_); unsigned char* ws = kp->ws; const float* rwkv_conv = kp->rwkv_conv; const float* rwkv_k_k = kp->rwkv_k_k;
    const bf16_t* RKVP = (const bf16_t*)(ws + A_TAIL); bf16_t* RKV = (bf16_t*)(ws + A_RKV); float* KN = (float*)(ws + OFF_KN);
    const int tidl = tid_l(); const int wave = tidl >> 6, lane = tidl & 63;
    const int gw = bid_l() * 8 + wave, nw = gridDim.x * 8;
    u32x2 tp[9], ntp[9]; f32x4 wt[9], nwt[9]; unsigned vm = 0u, nvm = 0u;
#define CV_LOAD(TP, WT, VM, task_) do { const int t_ = (task_) / 6, grp_ = (task_) - t_ * 6, ch_ = grp_ * 256 + lane * 4; \
        int rowbase_, y_, x_, H_, W_; \
        if (t_ < TX) { const int n_ = t_ & 4095; rowbase_ = t_ - n_; y_ = n_ >> 6; x_ = n_ & 63; H_ = 64; W_ = 64; } \
        else { const int n_ = (t_ - TX) & 255; rowbase_ = t_ - n_; y_ = 0; x_ = n_; H_ = 1; W_ = 256; } \
        VM = 0u; \
        _Pragma("unroll") for (int dy = 0; dy < 3; ++dy) _Pragma("unroll") for (int dx = 0; dx < 3; ++dx) { \
            const int yy_ = y_ + dy - 1, xx_ = x_ + dx - 1; const bool ok_ = (yy_ >= 0) && (yy_ < H_) && (xx_ >= 0) && (xx_ < W_); \
            const int row_ = ok_ ? rowbase_ + yy_ * W_ + xx_ : t_; VM |= ok_ ? (1u << (dy * 3 + dx)) : 0u; \
            TP[dy * 3 + dx] = *(const u32x2*)(RKVP + (size_t)row_ * 1536 + ch_); \
            WT[dy * 3 + dx] = *(const f32x4*)(rwkv_conv + (size_t)(dy * 3 + dx) * 1536 + ch_); } } while (0)
    if (gw < TT * 6) CV_LOAD(tp, wt, vm, gw);
    for (int task = gw; task < TT * 6; task += nw) {
        const int tnx = task + nw;
        if (tnx < TT * 6) CV_LOAD(ntp, nwt, nvm, tnx);
        const int t = task / 6, grp = task - t * 6, ch = grp * 256 + lane * 4;
        float a[4] = {0.f, 0.f, 0.f, 0.f};
#pragma unroll
        for (int q = 0; q < 9; ++q) { const float m = ((vm >> q) & 1u) ? 1.0f : 0.0f; const f32x4 cw = wt[q] * m;
            a[0] += bflo(tp[q].x) * cw[0]; a[1] += bfhi(tp[q].x) * cw[1]; a[2] += bflo(tp[q].y) * cw[2]; a[3] += bfhi(tp[q].y) * cw[3]; }
        u32x2 o; o.x = pk2(a[0], a[1]); o.y = pk2(a[2], a[3]);
        *(u32x2*)(RKV + (size_t)t * 1536 + ch) = o;
        if (grp == 2 || grp == 3) {
            const f32x4 kk = *(const f32x4*)(rwkv_k_k + ch - 512);
            const float k0 = bflo(o.x) * kk[0], k1 = bfhi(o.x) * kk[1], k2 = bflo(o.y) * kk[2], k3 = bfhi(o.y) * kk[3];
            float s = k0 * k0 + k1 * k1 + k2 * k2 + k3 * k3;
            s += __shfl_xor(s, 1); s += __shfl_xor(s, 2); s += __shfl_xor(s, 4); s += __shfl_xor(s, 8);
            if ((lane & 15) == 0) KN[(size_t)t * 8 + ((ch - 512) >> 6)] = rsqrtf(s + 1e-12f);
        }
#pragma unroll
        for (int q = 0; q < 9; ++q) { tp[q] = ntp[q]; wt[q] = nwt[q]; }
        vm = nvm;
    }
#undef CV_LOAD
}

__device__ __forceinline__ int scan_row(int dir, int b, int s) {
    if (s < CTXL) { const int n = dir ? (CTXL - 1 - s) : s; return TX + b * CTXL + n; }
    const int s2 = s - CTXL; const int n = dir ? (SEQ - 1 - s2) : s2; return b * SEQ + n;
}
constexpr int NCHUNK = (CTXL + SEQ) / 16;
constexpr int L_RB = 0;
constexpr int L_VB = 40960;
constexpr int L_YS = 45056;
constexpr int L_S5 = 49152;
constexpr int S5_WB = 14592 + 4096 + 4096;

struct PSet { u32x2 r, k, lw, a; float kn; unsigned v; };

__device__ __forceinline__ void scan_phase(KP kp_, unsigned char* smem) {
    KP_LAUNDER(kp, kp_); unsigned char* ws = kp->ws;
    const int tid = tid_l(), wave = __builtin_amdgcn_readfirstlane(tid >> 6), lane = tid & 63, wg = bid_l();
    bf16_t* YB = (bf16_t*)(ws + A_TAIL + (size_t)2 * TX * 512 * 2);
    float* RB = (float*)(smem + L_RB); float* VB = (float*)(smem + L_VB); float* YS = (float*)(smem + L_YS);
    const int rc = wg >> 1, half = wg & 1, rdir = rc >> 6, rb = (rc >> 3) & 7, rh = rc & 7;
    bf16_t* ybo = YB + (size_t)rdir * TX * 512 + rh * 64 + half * 32 + (tid & 31);
    const int yj = tid >> 5;
#define YSTORE(ci, buf) do { if ((ci) * 16 >= CTXL) { const size_t row = (size_t)scan_row(rdir, rb, (ci) * 16 + yj); ybo[row * 512] = (bf16_t)f2bf(YS[(buf) * 512 + tid]); } } while (0)
    if (wave < 4) {
        f32x2 S2[4];
#pragma unroll
        for (int i = 0; i < 4; ++i) S2[i] = (f32x2){0.f, 0.f};
        const int crow = wave * 8 + (lane >> 3), ccg = lane & 7;
        __syncthreads();
        for (int ci = 0; ci < NCHUNK; ++ci) {
            const int buf = ci & 1;
            const float* rbp = RB + (buf * 16) * 5 * 64 + ccg * 8;
            const float* vbp = VB + buf * 512 + crow;
            f32x4 cw[10], nw[10]; float cv, nv = 0.f;
#pragma unroll
            for (int q = 0; q < 10; ++q) cw[q] = *(const f32x4*)(rbp + (q >> 1) * 64 + (q & 1) * 4);
            cv = vbp[0];
            float yk0 = 0.f, yk1 = 0.f;
#pragma unroll
            for (int j = 0; j < 16; ++j) {
                if (j < 15) {
#pragma unroll
                    for (int q = 0; q < 10; ++q) nw[q] = *(const f32x4*)(rbp + (j + 1) * 320 + (q >> 1) * 64 + (q & 1) * 4);
                    nv = vbp[(j + 1) * 32];
                }
                const f32x2 vi2 = (f32x2){cv, cv};
                f32x2 d0 = S2[0] * (f32x2){cw[4][0], cw[4][1]}; d0 = S2[1] * (f32x2){cw[4][2], cw[4][3]} + d0;
                f32x2 d1 = S2[2] * (f32x2){cw[5][0], cw[5][1]}; d1 = S2[3] * (f32x2){cw[5][2], cw[5][3]} + d1;
                const f32x2 t0 = S2[0] * (f32x2){cw[0][0], cw[0][1]} + vi2 * (f32x2){cw[2][0], cw[2][1]};
                const f32x2 t1 = S2[1] * (f32x2){cw[0][2], cw[0][3]} + vi2 * (f32x2){cw[2][2], cw[2][3]};
                const f32x2 t2 = S2[2] * (f32x2){cw[1][0], cw[1][1]} + vi2 * (f32x2){cw[3][0], cw[3][1]};
                const f32x2 t3 = S2[3] * (f32x2){cw[1][2], cw[1][3]} + vi2 * (f32x2){cw[3][2], cw[3][3]};
                d0 = d0 + d1;
                const float sa = sum8(d0.x + d0.y);
                const f32x2 sa2 = (f32x2){sa, sa};
                S2[0] = sa2 * (f32x2){cw[6][0], cw[6][1]} + t0;
                S2[1] = sa2 * (f32x2){cw[6][2], cw[6][3]} + t1;
                S2[2] = sa2 * (f32x2){cw[7][0], cw[7][1]} + t2;
                S2[3] = sa2 * (f32x2){cw[7][2], cw[7][3]} + t3;
                f32x2 e0 = S2[0] * (f32x2){cw[8][0], cw[8][1]}; e0 = S2[1] * (f32x2){cw[8][2], cw[8][3]} + e0;
                f32x2 e1 = S2[2] * (f32x2){cw[9][0], cw[9][1]}; e1 = S2[3] * (f32x2){cw[9][2], cw[9][3]} + e1;
                e0 = e0 + e1;
                const float y = sum8(e0.x + e0.y);
                if (j < 8) yk0 = (ccg == j) ? y : yk0; else yk1 = (ccg == j - 8) ? y : yk1;
                if (j < 15) {
#pragma unroll
                    for (int q = 0; q < 10; ++q) cw[q] = nw[q];
                    cv = nv;
                }
            }
            YS[buf * 512 + ccg * 32 + crow] = yk0; YS[buf * 512 + (8 + ccg) * 32 + crow] = yk1;
            __syncthreads();
            YSTORE(ci, buf);
        }
    } else if (wave < 6) {
        const bf16_t* U = (const bf16_t*)(ws + A_U);
        bf16_t* YA = (bf16_t*)(ws + A_TAIL);
        const int sc = (wg * 2 + (wave - 4)) & 511, sdir = (sc >> 8) & 1, sb = (sc >> 5) & 7, sg = sc & 31;
        float s_sr = 0.f, s_si = 0.f; u32x4 su[4];
        float* XL = (float*)(smem + L_S5 + (wave - 4) * S5_WB); unsigned* SBU = (unsigned*)((unsigned char*)XL + 10240); const bf16_t* SBF = (const bf16_t*)SBU;
        const bf16_t* s5bb = (const bf16_t*)(ws + OFF_S5B) + (size_t)(sdir * 32 + sg) * 128 * 16;
        const bf16_t* s5cc = (const bf16_t*)(ws + OFF_S5C) + (size_t)(sdir * 32 + sg) * 16 * 128;
        const float* ab = (const float*)(ws + OFF_S5A) + (size_t)((sdir * 32 + sg) * 64 + lane) * 2;
        const float s_are = ab[0], s_aim = ab[1];
        const int n = lane & 15, q = lane >> 4;
        bf16_t* CL = (bf16_t*)((unsigned char*)XL + 14592); bf16_t* BL = CL + 2048;
#pragma unroll
        for (int i = 0; i < 4; ++i) { *(u32x4*)(CL + (lane + 64 * i) * 8) = *(const u32x4*)(s5cc + (lane + 64 * i) * 8);
            *(u32x4*)(BL + (lane + 64 * i) * 8) = *(const u32x4*)(s5bb + (lane + 64 * i) * 8); }
        const u32x4 s5mask = (lane < 32) ? (u32x4){0xffffffffu, 0xffffffffu, 0xffffffffu, 0xffffffffu} : (u32x4){0u, 0u, 0u, 0u};
#define S5_LOAD(Q, ci) do { const int ci_ = (ci) < NCHUNK ? (ci) : NCHUNK - 1; \
        const size_t row = (size_t)scan_row(sdir, sb, ci_ * 16 + n); (Q) = *(const u32x4*)(U + row * 512 + sg * 16 + 8 * (q & 1)); } while (0)
#define CFENCE() asm volatile("" ::: "memory")
        S5_LOAD(su[0], 0); S5_LOAD(su[1], 1); S5_LOAD(su[2], 2); S5_LOAD(su[3], 3);
        __syncthreads();
#define S5_BODY(XPH) \
            _Pragma("unroll") for (int dd = 0; dd < 4; ++dd) { \
                const int ci = cc + dd; const int buf = dd & 1; \
                const bf16x8 au = __builtin_bit_cast(bf16x8, su[dd] & s5mask); \
                _Pragma("unroll") for (int nb = 0; nb < 8; ++nb) { \
                    const bf16x8 bop = *(const bf16x8*)(BL + (16 * nb + n) * 16 + 8 * (q & 1)); \
                    const f32x4 xa = __builtin_amdgcn_mfma_f32_16x16x32_bf16(au, bop, (f32x4){0.f, 0.f, 0.f, 0.f}, 0, 0, 0); \
                    *(f32x4*)(XL + (16 * nb + n) * 20 + 4 * q) = xa; } \
                S5_LOAD(su[dd], ci + 4); \
                CFENCE(); \
                { f32x4 xr[4], xi[4]; \
                  _Pragma("unroll") for (int i = 0; i < 4; ++i) { xr[i] = *(const f32x4*)(XL + lane * 20 + 4 * i); xi[i] = *(const f32x4*)(XL + (64 + lane) * 20 + 4 * i); } \
                  _Pragma("unroll") for (int t = 0; t < 16; ++t) { \
                      const float nr = s_are * s_sr - s_aim * s_si + xr[t >> 2][t & 3]; \
                      const float ni = s_are * s_si + s_aim * s_sr + xi[t >> 2][t & 3]; \
                      s_sr = nr; s_si = ni; \
                      if (XPH) SBU[t * 68 + lane] = pk2(nr, ni); } } \
                CFENCE(); \
                if (XPH) { \
                    f32x4 ya = (f32x4){0.f, 0.f, 0.f, 0.f}; \
                    _Pragma("unroll") for (int ks = 0; ks < 4; ++ks) { \
                        const bf16x8 ay = *(const bf16x8*)(SBF + n * 136 + 32 * ks + 8 * q); \
                        const bf16x8 cop = *(const bf16x8*)(CL + n * 128 + 32 * ks + 8 * q); \
                        ya = __builtin_amdgcn_mfma_f32_16x16x32_bf16(ay, cop, ya, 0, 0, 0); } \
                    bf16_t* yo = YA + (size_t)sdir * TX * 512; \
                    _Pragma("unroll") for (int r = 0; r < 4; ++r) { const size_t row = (size_t)scan_row(sdir, sb, ci * 16 + 4 * q + r); yo[row * 512 + sg * 16 + n] = (bf16_t)f2bf(ya[r]); } } \
                CFENCE(); \
                __syncthreads(); \
                if (XPH) { const size_t row = (size_t)scan_row(rdir, rb, ci * 16 + yj); ybo[row * 512] = (bf16_t)f2bf(YS[buf * 512 + tid]); } \
            }
        for (int cc = 0; cc < CTXL / 16; cc += 4) { S5_BODY(false) }
        for (int cc = CTXL / 16; cc < NCHUNK; cc += 4) { S5_BODY(true) }
#undef S5_BODY
#undef S5_LOAD
#undef CFENCE
    } else {
        const bf16_t* RKV = (const bf16_t*)(ws + A_RKV); const bf16_t* LW = (const bf16_t*)(ws + A_LW); const bf16_t* AI = (const bf16_t*)(ws + A_R0);
        const float* KN = (const float*)(ws + OFF_KN);
        const int ptid = tid - 384, pj = (ptid >> 3) & 15, pc8 = (ptid & 7) * 8;
        float pkk[8], pka[8];
        struct PS8 { u32x4 r, k, lw, a; float kn; u32x2 v; };
        PS8 ps[4];
#pragma unroll
        for (int i = 0; i < 8; ++i) { pkk[i] = kp->rwkv_k_k[rh * 64 + pc8 + i]; pka[i] = kp->rwkv_k_a[rh * 64 + pc8 + i]; }
#define PROD_LOAD(P, ci) do { const int ci_ = (ci) < NCHUNK ? (ci) : NCHUNK - 1; const size_t row = (size_t)scan_row(rdir, rb, ci_ * 16 + pj); \
        (P).r = *(const u32x4*)(RKV + row * 1536 + rh * 64 + pc8); (P).k = *(const u32x4*)(RKV + row * 1536 + 512 + rh * 64 + pc8); \
        (P).lw = *(const u32x4*)(LW + row * 1024 + rdir * 512 + rh * 64 + pc8); (P).a = *(const u32x4*)(AI + row * 1024 + rdir * 512 + rh * 64 + pc8); \
        (P).kn = KN[row * 8 + rh]; (P).v = *(const u32x2*)(RKV + row * 1536 + 1024 + rh * 64 + half * 32 + (ptid & 7) * 4); } while (0)
#define PROD_STORE(P, buf) do { float* d = RB + (((buf) * 16 + pj) * 5) * 64 + pc8; \
        float k_[8], a_[8], l_[8], r_[8], w_[8], kt_[8], aa_[8], bb_[8]; \
        unpack8((P).k, k_); unpack8((P).a, a_); unpack8((P).lw, l_); unpack8((P).r, r_); \
        _Pragma("unroll") for (int i_ = 0; i_ < 8; ++i_) { const float kkv = k_[i_] * pkk[i_] * (P).kn; w_[i_] = __expf(l_[i_]); \
            kt_[i_] = k_[i_] * (1.0f + (a_[i_] - 1.0f) * pka[i_]); aa_[i_] = -kkv; bb_[i_] = kkv * a_[i_]; } \
        *(f32x4*)(d) = (f32x4){w_[0], w_[1], w_[2], w_[3]}; *(f32x4*)(d + 4) = (f32x4){w_[4], w_[5], w_[6], w_[7]}; \
        *(f32x4*)(d + 64) = (f32x4){kt_[0], kt_[1], kt_[2], kt_[3]}; *(f32x4*)(d + 68) = (f32x4){kt_[4], kt_[5], kt_[6], kt_[7]}; \
        *(f32x4*)(d + 128) = (f32x4){aa_[0], aa_[1], aa_[2], aa_[3]}; *(f32x4*)(d + 132) = (f32x4){aa_[4], aa_[5], aa_[6], aa_[7]}; \
        *(f32x4*)(d + 192) = (f32x4){bb_[0], bb_[1], bb_[2], bb_[3]}; *(f32x4*)(d + 196) = (f32x4){bb_[4], bb_[5], bb_[6], bb_[7]}; \
        *(f32x4*)(d + 256) = (f32x4){r_[0], r_[1], r_[2], r_[3]}; *(f32x4*)(d + 260) = (f32x4){r_[4], r_[5], r_[6], r_[7]}; \
        *(f32x4*)(VB + (buf) * 512 + pj * 32 + (ptid & 7) * 4) = (f32x4){bflo((P).v.x), bfhi((P).v.x), bflo((P).v.y), bfhi((P).v.y)}; } while (0)
        PROD_LOAD(ps[0], 0); PROD_STORE(ps[0], 0);
        PROD_LOAD(ps[1], 1); PROD_LOAD(ps[2], 2); PROD_LOAD(ps[3], 3); PROD_LOAD(ps[0], 4);
        __syncthreads();
#define PROD_BODY(XPH) \
            _Pragma("unroll") for (int dd = 0; dd < 4; ++dd) { \
                const int ci = cc + dd; const int buf = dd & 1; \
                __builtin_amdgcn_sched_barrier(0); \
                PROD_STORE(ps[(dd + 1) & 3], buf ^ 1); \
                __builtin_amdgcn_sched_barrier(0); \
                PROD_LOAD(ps[(dd + 1) & 3], ci + 5); \
                __builtin_amdgcn_sched_barrier(0); \
                __syncthreads(); \
                if (XPH) { const size_t row = (size_t)scan_row(rdir, rb, ci * 16 + yj); ybo[row * 512] = (bf16_t)f2bf(YS[buf * 512 + tid]); } \
            }
        for (int cc = 0; cc < CTXL / 16; cc += 4) { PROD_BODY(false) }
        for (int cc = CTXL / 16; cc < NCHUNK; cc += 4) { PROD_BODY(true) }
#undef PROD_BODY
#undef PROD_LOAD
#undef PROD_STORE
    }
#undef YSTORE
}

__device__ __forceinline__ void post_phase(KP kp_) {
    KP_LAUNDER(kp, kp_); unsigned char* ws = kp->ws;
    const int tidl = tid_l(); const int wave = tidl >> 6, lane = tidl & 63;
    const int gw = bid_l() * 8 + wave, nw = gridDim.x * 8;
    const bf16_t* YA = (const bf16_t*)(ws + A_TAIL); const bf16_t* YB = (const bf16_t*)(ws + A_TAIL + (size_t)2 * TX * 512 * 2);
    bf16_t* U = (bf16_t*)(ws + A_U); bf16_t* G = (bf16_t*)(ws + A_G);
    const bf16_t* RKV = (const bf16_t*)(ws + A_RKV); const bf16_t* AI = (const bf16_t*)(ws + A_R0);
    const int c8 = lane * 8;
    float dD[8], ka[8], rk[8], lg[8], lb[8];
#pragma unroll
    for (int j = 0; j < 8; ++j) { dD[j] = kp->s5_D[c8 + j]; ka[j] = kp->rwkv_k_a[c8 + j]; rk[j] = kp->rwkv_r_k[c8 + j]; lg[j] = kp->rwkv_ln_g[c8 + j]; lb[j] = kp->rwkv_ln_b[c8 + j]; }
    u32x4 c[11], nx[11];
#define PP_LOAD(A, t) do { A[0] = *(const u32x4*)(YA + (size_t)(t) * 512 + c8); A[1] = *(const u32x4*)(YA + (size_t)(TX + (t)) * 512 + c8); A[2] = *(const u32x4*)(U + (size_t)(t) * 512 + c8); \
        A[3] = *(const u32x4*)(YB + (size_t)(t) * 512 + c8); A[4] = *(const u32x4*)(YB + (size_t)(TX + (t)) * 512 + c8); \
        A[5] = *(const u32x4*)(RKV + (size_t)(t) * 1536 + c8); A[6] = *(const u32x4*)(RKV + (size_t)(t) * 1536 + 512 + c8); A[7] = *(const u32x4*)(RKV + (size_t)(t) * 1536 + 1024 + c8); \
        A[8] = *(const u32x4*)(AI + (size_t)(t) * 1024 + c8); A[9] = *(const u32x4*)(AI + (size_t)(t) * 1024 + 512 + c8); A[10] = *(const u32x4*)(G + (size_t)(t) * 512 + c8); } while (0)
    PP_LOAD(c, gw);
    for (int t = gw; t < TX; t += nw) {
        const int tn = t + nw;
        if (tn < TX) PP_LOAD(nx, tn);
        {
            float f[8], b[8], u[8], o[8];
            unpack8(c[0], f); unpack8(c[1], b); unpack8(c[2], u);
#pragma unroll
            for (int j = 0; j < 8; ++j) o[j] = geluf_(f[j] + b[j] + dD[j] * u[j]);
            *(u32x4*)(U + (size_t)t * 512 + c8) = pack8(o);
        }
        {
            float f[8], b[8], r[8], k[8], v[8], af[8], ab[8], g[8], o[8];
            unpack8(c[3], f); unpack8(c[4], b); unpack8(c[5], r); unpack8(c[6], k); unpack8(c[7], v); unpack8(c[8], af); unpack8(c[9], ab); unpack8(c[10], g);
            float s = 0.f, bs = 0.f;
#pragma unroll
            for (int j = 0; j < 8; ++j) { f[j] += b[j]; s += f[j];
                const float kt = k[j] * ((1.0f + (af[j] - 1.0f) * ka[j]) + (1.0f + (ab[j] - 1.0f) * ka[j]));
                bs += r[j] * kt * rk[j]; }
            s = sum8(s); bs = sum8(bs);
            const float mu = s * (1.0f / 64.0f);
            float q = 0.f;
#pragma unroll
            for (int j = 0; j < 8; ++j) { const float dlt = f[j] - mu; q += dlt * dlt; }
            q = sum8(q);
            const float rstd = rsqrtf(q * (1.0f / 64.0f) + 64e-5f);
#pragma unroll
            for (int j = 0; j < 8; ++j) o[j] = (((f[j] - mu) * rstd) * lg[j] + lb[j] + bs * v[j]) * g[j];
            *(u32x4*)(G + (size_t)t * 512 + c8) = pack8(o);
        }
#pragma unroll
        for (int i = 0; i < 11; ++i) c[i] = nx[i];
    }
#undef PP_LOAD
}

__global__ void __launch_bounds__(NTHR, 2) fwd_megakernel(Params p_unused) {
    extern __shared__ __attribute__((aligned(16))) unsigned char smem[];
    cg::grid_group grid = cg::this_grid();
    KP kp0 = (KP)__builtin_amdgcn_kernarg_segment_ptr();
#define PH_BEGIN KP_LAUNDER(kp, kp0); unsigned char* ws = kp->ws; const float* MOD = (const float*)(ws + OFF_MOD); float* XC1 = (float*)(ws + OFF_XC1); (void)MOD; (void)XC1;

    volatile LAS unsigned* bst = (volatile LAS unsigned*)((LAS unsigned char*)smem + 131072);
    if (threadIdx.x < 2) bst[threadIdx.x] = 0u;
    { KP_LAUNDER(kpb, kp0); unsigned* bw = (unsigned*)(kpb->ws + OFF_BAR);
      if (blockIdx.x == 0) for (int i = threadIdx.x; i < XCD_BAR_WORDS; i += NTHR) bw[i] = 0u; }
    __syncthreads();
    phase0(kp0, smem);
    grid.sync();
    { KP_LAUNDER(kpb, kp0); (void)xcd_barrier_post((unsigned*)(kpb->ws + OFF_BAR), bst); }
#define GRID_BAR() do { KP_LAUNDER(kpb, kp0); XcdBarrier xb_; xb_.bar = (unsigned*)(kpb->ws + OFF_BAR); xb_.x = xb_xcc_id(); \
        xb_.st = (volatile LAS unsigned*)((LAS unsigned char*)smem + 131072); xcd_barrier(xb_); } while (0)
    { PH_BEGIN norm_phase(kp->x, kp->ctx, TT, kp->norm_g, MOD, 0, (bf16_t*)(ws + A_R0)); }
    GRID_BAR();
    { PH_BEGIN EpiGU e; e.O = (bf16_t*)(ws + A_ACT); run_gemm(smem, (const bf16_t*)(ws + A_R0), (const bf16_t*)(ws + OFF_WGU1), TT, 2 * FF, D, e); }
    GRID_BAR();
    { PH_BEGIN EpiRes e; e.srcx = kp->x; e.dstx = kp->out; e.srcc = kp->ctx; e.dstc = XC1; e.mod = MOD + 2 * 1024; e.scale = 0.5f; e.rowoff = 0;
      run_gemm(smem, (const bf16_t*)(ws + A_ACT), (const bf16_t*)(ws + OFF_WD1), TX, D, FF, e); }
    GRID_BAR();
    if (bid_l() < 32) {
        PH_BEGIN EpiRes e; e.srcx = kp->x; e.dstx = kp->out; e.srcc = kp->ctx; e.dstc = XC1; e.mod = MOD + 2 * 1024; e.scale = 0.5f; e.rowoff = TX;
        run_gemm(smem, (const bf16_t*)(ws + A_ACT) + (size_t)TX * FF, (const bf16_t*)(ws + OFF_WD1), TC, D, FF, e, 32, bid_l());
    } else {
        PH_BEGIN norm_phase(kp->out, XC1, TX, kp->norm_g + 1024, MOD, 3, (bf16_t*)(ws + A_R0), 0, bid_l() - 32, 224);
    }
    GRID_BAR();
    { PH_BEGIN norm_phase(kp->out, XC1, TT, kp->norm_g + 1024, MOD, 3, (bf16_t*)(ws + A_R0), TX); }
    GRID_BAR();
    { PH_BEGIN EpiIn e; e.U = (bf16_t*)(ws + A_U); e.RKVP = (bf16_t*)(ws + A_TAIL); e.LA = (bf16_t*)(ws + A_LA);
      run_gemm(smem, (const bf16_t*)(ws + A_R0), (const bf16_t*)(ws + OFF_WIN1), TT, 2560, D, e); }
    GRID_BAR();
    { PH_BEGIN EpiLora e; e.wsb = ws; e.w0 = kp->rwkv_w0; e.a0 = kp->rwkv_a0;
      run_gemm(smem, (const bf16_t*)(ws + A_LA), (const bf16_t*)(ws + OFF_WLORA), TT, 2560, 384, e); }
    conv_phase(kp0);
    GRID_BAR();
    scan_phase(kp0, smem);
    GRID_BAR();
    post_phase(kp0);
    { PH_BEGIN norm_phase(kp->out, XC1, TX, kp->norm_g + 1024, MOD, 3, (bf16_t*)(ws + A_LW)); }
    GRID_BAR();
    { PH_BEGIN EpiBf<0> e; e.O = (bf16_t*)(ws + A_TAIL); e.ld = 2048; e.aux = nullptr; e.ldaux = 0;
      run_gemm(smem, (const bf16_t*)(ws + A_LW), (const bf16_t*)(ws + OFF_WGATE), TX, 2048, D, e); }
    { PH_BEGIN EpiBf<1> e; e.O = (bf16_t*)(ws + A_R0); e.ld = 512; e.aux = (const bf16_t*)(ws + A_U); e.ldaux = 512;
      run_gemm(smem, (const bf16_t*)(ws + A_U), (const bf16_t*)(ws + OFF_WGLU), TX, 512, 512, e); }
    GRID_BAR();
    { PH_BEGIN EpiBf<2> e; e.O = (bf16_t*)(ws + A_RKV); e.ld = 1024; e.aux = (const bf16_t*)(ws + A_TAIL); e.ldaux = 2048;
      run_gemm(smem, (const bf16_t*)(ws + A_R0), (const bf16_t*)(ws + OFF_WPROJ), TX, D, 512, e); }
    { PH_BEGIN EpiBf<3> e; e.O = (bf16_t*)(ws + A_RKV); e.ld = 1024; e.aux = (const bf16_t*)(ws + A_TAIL); e.ldaux = 2048;
      run_gemm(smem, (const bf16_t*)(ws + A_G), (const bf16_t*)(ws + OFF_WO), TX, D, 512, e); }
    GRID_BAR();
    { PH_BEGIN EpiRes e; e.srcx = kp->out; e.dstx = kp->out; e.srcc = XC1; e.dstc = XC1; e.mod = MOD + 5 * 1024; e.scale = 1.0f; e.rowoff = 0;
      run_gemm(smem, (const bf16_t*)(ws + A_RKV), (const bf16_t*)(ws + OFF_WOUT), TX, D, D, e); }
    GRID_BAR();
    { PH_BEGIN norm_phase(kp->out, XC1, TX, kp->norm_g + 2048, MOD, 6, (bf16_t*)(ws + A_R0)); }
    GRID_BAR();
    { PH_BEGIN EpiGU e; e.O = (bf16_t*)(ws + A_ACT); run_gemm(smem, (const bf16_t*)(ws + A_R0), (const bf16_t*)(ws + OFF_WGU2), TX, 2 * FF, D, e); }
    GRID_BAR();
    { PH_BEGIN EpiRes e; e.srcx = kp->out; e.dstx = kp->out; e.srcc = XC1; e.dstc = XC1; e.mod = MOD + 8 * 1024; e.scale = 0.5f; e.rowoff = 0;
      run_gemm(smem, (const bf16_t*)(ws + A_ACT), (const bf16_t*)(ws + OFF_WD2), TX, D, FF, e); }
    GRID_BAR();
    { PH_BEGIN final_norm_phase(kp->out, kp->final_g); }
}

extern "C" void kernel_launch(void* const* d_in, const int* in_sizes, int n_in, void* d_out, int out_size, void* d_ws, size_t ws_size, hipStream_t stream) {
    static int grid_blocks = 0;
    if (grid_blocks == 0) {
        if (n_in != 35 || out_size != TX * D || ws_size < WS_NEED) { fprintf(stderr, "kernel_launch: unexpected shapes n_in %d out %d ws %zu\n", n_in, out_size, ws_size); grid_blocks = -1; return; }
        int dev = 0, cus = 0, per_cu = 0;
        hipGetDevice(&dev);
        hipDeviceGetAttribute(&cus, hipDeviceAttributeMultiprocessorCount, dev);
        hipFuncSetAttribute((const void*)fwd_megakernel, hipFuncAttributeMaxDynamicSharedMemorySize, LDS_BYTES);
        hipOccupancyMaxActiveBlocksPerMultiprocessor(&per_cu, (const void*)fwd_megakernel, NTHR, LDS_BYTES);
        if (per_cu < 1) { fprintf(stderr, "kernel_launch: occupancy query says %d blocks per CU\n", per_cu); per_cu = 1; }
        (void)hipGetLastError();
        grid_blocks = cus;
        if (grid_blocks != 256) fprintf(stderr, "kernel_launch: %d CUs; the scan phase is laid out for 256 workgroups\n", grid_blocks);
        grid_blocks = 256;
    }
    if (grid_blocks < 0) return;
    Params p{};
    const float** pp = (const float**)&p;
    for (int i = 0; i < 35; ++i) pp[i] = (const float*)d_in[i];
    p.out = (float*)d_out; p.ws = (unsigned char*)d_ws;
    void* args[] = {&p};
    hipError_t e = hipLaunchCooperativeKernel((const void*)fwd_megakernel, dim3(grid_blocks), dim3(NTHR), args, LDS_BYTES, stream);
    if (e != hipSuccess) fprintf(stderr, "cooperative launch failed: %s (grid %d)\n", hipGetErrorString(e), grid_blocks);
}
```
